# Optimizing an MI355X kernel written in HIP

```python
import math
import jax, jax.numpy as jnp
from jax import lax
import numpy as np

D_MODEL = 1024
BATCH = 8
SEQ = 4096
DEPTH = 2

HG_HEAD_DIM = 128
HG_HEADS = D_MODEL // HG_HEAD_DIM
HG_DIM = HG_HEADS * HG_HEAD_DIM
GLA_HEADS = 4
GLA_KEY_DIM = D_MODEL // 2
GLA_VALUE_DIM = D_MODEL
GLA_HEAD_K = GLA_KEY_DIM // GLA_HEADS
GLA_HEAD_V = GLA_VALUE_DIM // GLA_HEADS
GLA_GATE_RANK = 16
GLA_GATE_NORMALIZER = 16.0
GLA_IN_DIM = 2 * GLA_KEY_DIM + 2 * GLA_VALUE_DIM + GLA_GATE_RANK
D_FF = 2816
CONV_WIDTH = 3
CHUNK = 64
EPS = 1e-6
N_HG_LAYERS = (DEPTH + 1) // 2
N_GLA_LAYERS = DEPTH // 2

kernel_name = "hybrid_hgrn2_gla_convglu"


def rmsnorm(x, w):
    xf = x.astype(jnp.float32)
    xf = xf * lax.rsqrt(jnp.mean(xf * xf, axis=-1, keepdims=True) + EPS)
    return (xf * w.astype(jnp.float32)).astype(x.dtype)


def chunk_gated_linear_attention(q, k, v, log_f):
    B, T, H, dk = q.shape
    dv = v.shape[-1]
    N = T // CHUNK

    def to_chunks(a):
        return a.astype(jnp.float32).reshape(B, N, CHUNK, H, a.shape[-1]).transpose(1, 0, 3, 2, 4)

    qc = to_chunks(q) * (dk ** -0.5)
    kc, vc, gc = to_chunks(k), to_chunks(v), to_chunks(log_f)
    causal = jnp.tril(jnp.ones((CHUNK, CHUNK), dtype=bool))

    def step(S, chunk):
        q_, k_, v_, g_ = chunk
        b = jnp.cumsum(g_, axis=2)
        diff = b[:, :, :, None, :] - b[:, :, None, :, :]
        decay = jnp.exp(jnp.where(causal[:, :, None], diff, -jnp.inf))
        scores = jnp.einsum('bhtd,bhtsd,bhsd->bhts', q_, decay, k_)
        o = (jnp.einsum('bhts,bhsv->bhtv', scores, v_)
             + jnp.einsum('bhtd,bhdv->bhtv', q_ * jnp.exp(b), S))
        b_last = b[:, :, -1:, :]
        S = (jnp.exp(b_last[:, :, 0, :])[..., None] * S
             + jnp.einsum('bhsd,bhsv->bhdv', k_ * jnp.exp(b_last - b), v_))
        return S, o

    S0 = jnp.zeros((B, H, dk, dv), jnp.float32)
    _, o = lax.scan(step, S0, (qc, kc, vc, gc))
    return o.transpose(1, 0, 3, 2, 4).reshape(B, T, H, dv)


def gated_head_norm(o, g, norm_w, out_dtype):
    B, T, H, dv = o.shape
    o = o * lax.rsqrt(jnp.mean(o * o, axis=-1, keepdims=True) + EPS) * norm_w.astype(jnp.float32)
    o = o.reshape(B, T, H * dv) * jax.nn.silu(g.astype(jnp.float32))
    return o.astype(out_dtype)


def hgrn2_mixer(h, w_in, lb, norm_w, w_out):
    B, T, _ = h.shape
    proj = h @ w_in
    q, f, i, g = jnp.split(proj, 4, axis=-1)
    q = jax.nn.silu(q)
    forget = lb + (1.0 - lb) * jax.nn.sigmoid(f.astype(jnp.float32))
    k = 1.0 - forget
    log_f = jnp.log(forget)
    heads = lambda a: a.reshape(B, T, HG_HEADS, HG_HEAD_DIM)
    o = chunk_gated_linear_attention(heads(q), heads(k), heads(i), heads(log_f))
    return gated_head_norm(o, g, norm_w, h.dtype) @ w_out


def gla_mixer(h, w_in, w_gk_up, b_gk_up, norm_w, w_out):
    B, T, _ = h.shape
    proj = h @ w_in
    splits = np.cumsum([GLA_KEY_DIM, GLA_KEY_DIM, GLA_VALUE_DIM, GLA_VALUE_DIM]).tolist()
    q, k, v, g, gate_lr = jnp.split(proj, splits, axis=-1)
    gk = (gate_lr @ w_gk_up + b_gk_up).astype(jnp.float32)
    log_f = jax.nn.log_sigmoid(gk) / GLA_GATE_NORMALIZER
    hk = lambda a: a.reshape(B, T, GLA_HEADS, GLA_HEAD_K)
    o = chunk_gated_linear_attention(hk(q), hk(k), v.reshape(B, T, GLA_HEADS, GLA_HEAD_V), hk(log_f))
    return gated_head_norm(o, g, norm_w, h.dtype) @ w_out


def conv_glu_ffn(h, w_up, conv_w, conv_b, w_down):
    T = h.shape[1]
    u = h @ w_up
    up = jnp.pad(u, ((0, 0), (CONV_WIDTH - 1, 0), (0, 0)))
    u = conv_b + sum(conv_w[j] * up[:, j:j + T] for j in range(CONV_WIDTH))
    a, gate = jnp.split(u, 2, axis=-1)
    return (jax.nn.silu(gate) * a) @ w_down


def setup_inputs(seed: int = 0) -> dict:
    key = jax.random.key(seed)
    ks = jax.random.split(key, 20)
    nrm = lambda k, shape, fan_in: jax.random.normal(k, shape, jnp.float32) * (fan_in ** -0.5)
    gain = lambda k, shape: 1.0 + 0.02 * jax.random.normal(k, shape, jnp.float32)
    return {
        "x": jax.random.normal(ks[0], (BATCH, SEQ, D_MODEL), jnp.float32),
        "lb_logits": 0.1 * jax.random.normal(ks[1], (DEPTH + 1, HG_DIM), jnp.float32),
        "hg_w_in": nrm(ks[2], (N_HG_LAYERS, D_MODEL, 4 * HG_DIM), D_MODEL),
        "hg_norm_w": gain(ks[3], (N_HG_LAYERS, HG_HEAD_DIM)),
        "hg_w_out": nrm(ks[4], (N_HG_LAYERS, HG_DIM, D_MODEL), HG_DIM),
        "gla_w_in": nrm(ks[5], (N_GLA_LAYERS, D_MODEL, GLA_IN_DIM), D_MODEL),
        "gla_w_gk_up": nrm(ks[6], (N_GLA_LAYERS, GLA_GATE_RANK, GLA_KEY_DIM), GLA_GATE_RANK),
        "gla_b_gk_up": 0.1 * jax.random.normal(ks[7], (N_GLA_LAYERS, GLA_KEY_DIM), jnp.float32),
        "gla_norm_w": gain(ks[8], (N_GLA_LAYERS, GLA_HEAD_V)),
        "gla_w_out": nrm(ks[9], (N_GLA_LAYERS, GLA_VALUE_DIM, D_MODEL), GLA_VALUE_DIM),
        "norm_mixer_w": gain(ks[10], (DEPTH, D_MODEL)),
        "norm_ffn_w": gain(ks[11], (DEPTH, D_MODEL)),
        "ffn_w_up": nrm(ks[12], (DEPTH, D_MODEL, 2 * D_FF), D_MODEL),
        "ffn_conv_w": nrm(ks[13], (DEPTH, CONV_WIDTH, 2 * D_FF), CONV_WIDTH),
        "ffn_conv_b": 0.02 * jax.random.normal(ks[14], (DEPTH, 2 * D_FF), jnp.float32),
        "ffn_w_down": nrm(ks[15], (DEPTH, D_FF, D_MODEL), D_FF),
        "norm_final_w": gain(ks[16], (D_MODEL,)),
    }


def reference(x, lb_logits, hg_w_in, hg_norm_w, hg_w_out, gla_w_in, gla_w_gk_up, gla_b_gk_up,
              gla_norm_w, gla_w_out, norm_mixer_w, norm_ffn_w, ffn_w_up, ffn_conv_w, ffn_conv_b,
              ffn_w_down, norm_final_w):
    lb_table = jnp.cumsum(jax.nn.softmax(lb_logits.astype(jnp.float32), axis=0), axis=0)
    h = x
    for i in range(DEPTH):
        y = rmsnorm(h, norm_mixer_w[i])
        j = i // 2
        if i % 2 == 0:
            mix = hgrn2_mixer(y, hg_w_in[j], lb_table[i], hg_norm_w[j], hg_w_out[j])
        else:
            mix = gla_mixer(y, gla_w_in[j], gla_w_gk_up[j], gla_b_gk_up[j], gla_norm_w[j], gla_w_out[j])
        h = h + mix
        y = rmsnorm(h, norm_ffn_w[i])
        h = h + conv_glu_ffn(y, ffn_w_up[i], ffn_conv_w[i], ffn_conv_b[i], ffn_w_down[i])
    return rmsnorm(h, norm_final_w)
```

```cpp
#include <hip/hip_runtime.h>
#include <hip/hip_cooperative_groups.h>
#include <cstdio>
namespace cg = cooperative_groups;
namespace pg8 {
#define PG8_LAS __attribute__((address_space(3)))
typedef unsigned short bf16_t;
typedef short bf16x8 __attribute__((ext_vector_type(8)));
typedef float f32x4 __attribute__((ext_vector_type(4)));
typedef unsigned u32x4 __attribute__((ext_vector_type(4)));
constexpr int BM = 256, BK = 64, HALF = 128, HTB = HALF * BK * 2  , STAGE_BYTES = 8 * HTB, NXCD = 8, WGM = 4;

__host__ __device__ __forceinline__ int lds_byte(int r, int c) { const int st = (r >> 4) * 2 + (c >> 5), rr = r & 15, cc = c & 31, ob = rr * 64 + cc * 2; return st * 1024 + (ob ^ (((ob >> 9) & 1) << 5)); }
__host__ __device__ __forceinline__ void stage_rc(int b, int& R, int& C) { const int st = b / 1024, sb = b % 1024, swz = sb ^ (((sb >> 9) & 1) << 5); R = (st >> 1) * 16 + swz / 64; C = (st & 1) * 32 + (swz % 64) / 2; }
__host__ __device__ __forceinline__ int perm32(int rho) { const int n = rho >> 4, i = rho & 15; return 8 * (i >> 2) + 4 * n + (i & 3); }

struct Unit { int pm, pn; };
struct Gemm { const bf16_t* A; const bf16_t* Bt; int M, N, K; };

struct StaticOrder {
    int nM, nN, nwg, G, c;
    __host__ __device__ void init(int M, int N, int G_, int c_) { nM = M / BM; nN = N / BM; nwg = nM * nN; G = G_; c = c_; }
    __host__ __device__ bool next(int i, Unit& u) const {
        const long L = (long)i * G + c; if (L >= nwg) return false;
        int wgid = (int)L; { const int q = nwg / NXCD, r = nwg % NXCD, xcd = wgid % NXCD, off = wgid / NXCD; wgid = (xcd < r ? xcd * (q + 1) : r * (q + 1) + (xcd - r) * q) + off; }
        const int nig = WGM * nN, gid = wgid / nig, fm = gid * WGM, gsz = (nM - fm) < WGM ? (nM - fm) : WGM;
        u.pm = fm + ((wgid % nig) % gsz); u.pn = (wgid % nig) / gsz; return true;
    }
    __device__ __forceinline__ void a_ready(const Unit&) const {}
    __device__ __forceinline__ void done(const Unit&) const {}
};
typedef float f32x2_ __attribute__((ext_vector_type(2)));
typedef __bf16 bf16v2_ __attribute__((ext_vector_type(2)));
__device__ __forceinline__ unsigned cvt_pk_bf16(float lo, float hi) { f32x2_ v = {lo, hi}; bf16v2_ r = __builtin_convertvector(v, bf16v2_); return __builtin_bit_cast(unsigned, r); }
__device__ __forceinline__ float fsilu(float x) { return x * __builtin_amdgcn_rcpf(1.0f + __expf(-x)); }
__device__ __forceinline__ float fsigm(float x) { return __builtin_amdgcn_rcpf(1.0f + __expf(-x)); }

__device__ __forceinline__ void dpp_shr12(float x, float& s1, float& s2) {
    asm volatile("s_nop 1\n\tv_mov_b32_dpp %0, %2 row_shr:1 row_mask:0xf bank_mask:0xf bound_ctrl:1\n\tv_mov_b32_dpp %1, %2 row_shr:2 row_mask:0xf bank_mask:0xf bound_ctrl:1" : "=&v"(s1), "=&v"(s2) : "v"(x)); }
__device__ __forceinline__ void dpp_ror12(float x, float& s1, float& s2) {
    asm volatile("s_nop 1\n\tv_mov_b32_dpp %0, %2 row_ror:1 row_mask:0xf bank_mask:0xf\n\tv_mov_b32_dpp %1, %2 row_ror:2 row_mask:0xf bank_mask:0xf" : "=&v"(s1), "=&v"(s2) : "v"(x)); }
__device__ __forceinline__ float row_ssq16(const unsigned long long* rs, int row) { return (float)rs[row] * (1.0f / 1048576.0f); }
struct EpiRes {
    static constexpr bool PERM = false, AFTER_DRAIN = false;
    const float* base; float* out; int ldc;
    const bf16_t* baseb;
    bf16_t* hb;
    unsigned long long* ssq;
    int ntout;
    int nof32;
    __device__ __forceinline__ void operator()(const f32x4 (&acc)[2][2][4][2], const Unit& u, int wr, int wc, int fr, int fq) const {
        const int row0 = u.pm * BM + wr * 64 + fr, col0 = u.pn * BM + wc * 32 + 4 * fq;
#pragma unroll
        for (int ai = 0; ai < 2; ++ai)
#pragma unroll
            for (int m = 0; m < 4; ++m) { const int row = row0 + ai * HALF + m * 16; const size_t ro = (size_t)row * ldc + col0; float part = 0.f;
#pragma unroll
                for (int bj = 0; bj < 2; ++bj)
#pragma unroll
                    for (int n = 0; n < 2; ++n) { f32x4 b; if (baseb) { const unsigned long long t = *(const unsigned long long*)(baseb + ro + bj * HALF + n * 16); const unsigned lo = (unsigned)t, hi = (unsigned)(t >> 32);
                            b = (f32x4){__builtin_bit_cast(float, lo << 16), __builtin_bit_cast(float, lo & 0xffff0000u), __builtin_bit_cast(float, hi << 16), __builtin_bit_cast(float, hi & 0xffff0000u)}; }
                        else b = *(const f32x4*)(base + ro + bj * HALF + n * 16); const f32x4 v = acc[ai][bj][m][n] + b; if (!nof32) { if (ntout) __builtin_nontemporal_store(v, (f32x4*)(out + ro + bj * HALF + n * 16)); else *(f32x4*)(out + ro + bj * HALF + n * 16) = v; }
                        part += (v[0] * v[0] + v[1] * v[1]) + (v[2] * v[2] + v[3] * v[3]);
                        if (hb) { unsigned lo = cvt_pk_bf16(v[0], v[1]), hi = cvt_pk_bf16(v[2], v[3]); *(unsigned long long*)(hb + ro + bj * HALF + n * 16) = (unsigned long long)lo | ((unsigned long long)hi << 32); } }
                if (ssq) { part += __shfl_xor(part, 16); part += __shfl_xor(part, 32); if (fq == 0) atomicAdd(ssq + row, (unsigned long long)(part * 1048576.0f + 0.5f)); } }
    }
};

struct EpiProj {
    static constexpr bool PERM = true, AFTER_DRAIN = false;
    int kind;
    bf16_t *o0, *o1, *o2, *o3, *o4;
    const float* aux;
    int ldplain;
    const float* cw; const float* cb;
    bf16_t* halo;
    const unsigned long long* rs;
    __device__ __forceinline__ void glu(const f32x4 (&acc)[2][2][4][2], const Unit& u, int wr, int wc, int fr, int fq) const {
        const int ch0 = u.pn * 128 + wc * 32 + 8 * fq;
#pragma unroll
        for (int ai = 0; ai < 2; ++ai) {
            const int rowg = u.pm * BM + ai * HALF + wr * 64;
            float rstd[4];
#pragma unroll
            for (int m = 0; m < 4; ++m) rstd[m] = 1.0f / sqrtf(row_ssq16(rs, rowg + 16 * m + fr) * (1.0f / 1024.0f) + 1e-6f);
#pragma unroll
            for (int hm = 0; hm < 2; ++hm) { const int m = hm ? 3 : 0; const bool doit = hm ? (fr >= 14) : (fr < 2); const int slot = hm ? (fr - 12) : fr;
                if (doit) { bf16_t* hp = halo + ((size_t)(rowg >> 6) * 4 + slot) * 5632 + ch0;
#pragma unroll
                    for (int bj = 0; bj < 2; ++bj) { const f32x4 v0 = acc[ai][bj][m][0] * rstd[m], v1 = acc[ai][bj][m][1] * rstd[m];
                        u32x4 w; w.x = cvt_pk_bf16(v0[0], v0[1]); w.y = cvt_pk_bf16(v0[2], v0[3]); w.z = cvt_pk_bf16(v1[0], v1[1]); w.w = cvt_pk_bf16(v1[2], v1[3]);
                        *(u32x4*)(hp + bj * 2816) = w; } } }
#pragma unroll
            for (int n = 0; n < 2; ++n) { const int ch = ch0 + 4 * n;
                const f32x4 wa0 = *(const f32x4*)(cw + ch), wa1 = *(const f32x4*)(cw + 5632 + ch), wa2 = *(const f32x4*)(cw + 2 * 5632 + ch), ba = *(const f32x4*)(cb + ch);
                const f32x4 wg0 = *(const f32x4*)(cw + 2816 + ch), wg1 = *(const f32x4*)(cw + 5632 + 2816 + ch), wg2 = *(const f32x4*)(cw + 2 * 5632 + 2816 + ch), bg = *(const f32x4*)(cb + 2816 + ch);
                f32x4 pa = (f32x4){0.f, 0.f, 0.f, 0.f}, pg = (f32x4){0.f, 0.f, 0.f, 0.f};
#pragma unroll
                for (int m = 0; m < 4; ++m) { const f32x4 xa = acc[ai][0][m][n] * rstd[m], xg = acc[ai][1][m][n] * rstd[m]; float r[4];
#pragma unroll
                    for (int j = 0; j < 4; ++j) {
                        float sa1, sa2, sg1, sg2; dpp_shr12(xa[j], sa1, sa2); dpp_shr12(xg[j], sg1, sg2);
                        float qa1, qa2, qg1, qg2; dpp_ror12(pa[j], qa1, qa2); dpp_ror12(pg[j], qg1, qg2);
                        const float pa1 = fr >= 1 ? sa1 : qa1, pa2 = fr >= 2 ? sa2 : qa2, pg1 = fr >= 1 ? sg1 : qg1, pg2 = fr >= 2 ? sg2 : qg2;
                        const float ua = ba[j] + wa0[j] * pa2 + wa1[j] * pa1 + wa2[j] * xa[j];
                        const float ug = bg[j] + wg0[j] * pg2 + wg1[j] * pg1 + wg2[j] * xg[j];
                        r[j] = fsilu(ug) * ua; }
                    pa = xa; pg = xg;
                    if (!(m == 0 && fr < 2)) { const unsigned lo = cvt_pk_bf16(r[0], r[1]), hi = cvt_pk_bf16(r[2], r[3]);
                        *(unsigned long long*)(o0 + (size_t)(rowg + 16 * m + fr) * 2816 + ch) = (unsigned long long)lo | ((unsigned long long)hi << 32); }
                    __builtin_amdgcn_sched_barrier(0); } }
        }
    }
    __device__ __forceinline__ void operator()(const f32x4 (&acc)[2][2][4][2], const Unit& u, int wr, int wc, int fr, int fq) const {
        if (kind == 3) { glu(acc, u, wr, wc, fr, fq); return; }
        int mode = 0, ld = ldplain, colt = u.pn * BM; bf16_t* ob = o0; bf16_t* ob2 = o0; float scale = 1.0f;
        bool nt = true;
        if (kind == 0) { const int sec = u.pn >> 2; colt = (u.pn & 3) * BM; ld = 1024;
            if (sec == 0) { mode = 1; ob = o0; scale = 0.08838834764831845f; } else if (sec == 1) { mode = 2; ob = o1; ob2 = o2; nt = false; } else if (sec == 2) { ob = o3; nt = false; } else { ob = o4; } }
        else if (kind == 1) { const int pn = u.pn;
            if (pn < 2) { ob = o0; ld = 512; colt = pn * BM; scale = 0.08838834764831845f; }
            else if (pn < 4) { ob = o1; ld = 512; colt = (pn - 2) * BM; nt = false; }
            else if (pn < 8) { ob = o3; ld = 1024; colt = (pn - 4) * BM; nt = false; }
            else if (pn < 12) { ob = o4; ld = 1024; colt = (pn - 8) * BM; }
            else { mode = 3; ob = o2; ld = 512; colt = (pn - 12) * BM; nt = false; } }
        const int row0 = u.pm * BM + wr * 64 + fr, col0 = colt + wc * 32 + 8 * fq;
        f32x4 av[2][2];
#pragma unroll
        for (int bj = 0; bj < 2; ++bj)
#pragma unroll
            for (int n = 0; n < 2; ++n) av[bj][n] = (mode >= 2) ? *(const f32x4*)(aux + col0 + bj * HALF + 4 * n) : (f32x4){0.f, 0.f, 0.f, 0.f};
#pragma unroll
        for (int ai = 0; ai < 2; ++ai)
#pragma unroll
            for (int m = 0; m < 4; ++m) { const size_t ro = (size_t)(row0 + ai * HALF + m * 16) * ld + col0;
                const float rstd = rs ? (1.0f / sqrtf(row_ssq16(rs, row0 + ai * HALF + m * 16) * (1.0f / 1024.0f) + 1e-6f)) : 1.0f;
                const float rsc = (mode == 1) ? rstd : rstd * scale;
#pragma unroll
                for (int bj = 0; bj < 2; ++bj) { f32x4 v0 = acc[ai][bj][m][0] * rsc, v1 = acc[ai][bj][m][1] * rsc;
                    if (mode == 0) { }
                    else if (mode == 1) {
#pragma unroll
                        for (int j = 0; j < 4; ++j) { v0[j] = fsilu(v0[j]) * scale; v1[j] = fsilu(v1[j]) * scale; } }
                    else if (mode == 2) {
#pragma unroll
                        for (int j = 0; j < 4; ++j) { const float lb0 = av[bj][0][j], lb1 = av[bj][1][j]; v0[j] = (1.0f - lb0) * fsigm(-v0[j]); v1[j] = (1.0f - lb1) * fsigm(-v1[j]); } }
                    else {
#pragma unroll
                        for (int j = 0; j < 4; ++j) { const float x0 = v0[j] + av[bj][0][j], x1 = v1[j] + av[bj][1][j];
                            v0[j] = (fminf(x0, 0.f) - __logf(1.0f + __expf(-fabsf(x0)))) * (0.0625f * 1.4426950408889634f); v1[j] = (fminf(x1, 0.f) - __logf(1.0f + __expf(-fabsf(x1)))) * (0.0625f * 1.4426950408889634f);   } }
                    u32x4 w; w.x = cvt_pk_bf16(v0[0], v0[1]); w.y = cvt_pk_bf16(v0[2], v0[3]); w.z = cvt_pk_bf16(v1[0], v1[1]); w.w = cvt_pk_bf16(v1[2], v1[3]);
                    if (nt) __builtin_nontemporal_store(w, (u32x4*)(ob + ro + bj * HALF)); else *(u32x4*)(ob + ro + bj * HALF) = w; } }
    }
};
template <class Epi, class Sched, bool ALIGN_EPI = false, bool SP2 = false>
__device__ __forceinline__ void gemm_phase(PG8_LAS unsigned char* lds, const Gemm g, const Sched& S, const Epi& E) {
    int tid_ = threadIdx.x; asm volatile("" : "+v"(tid_)); const int tid = tid_, wid = __builtin_amdgcn_readfirstlane(tid >> 6), lane = tid & 63, wr = wid >> 2, wc = wid & 3, fr = lane & 15, fq = lane >> 4;
    const int K = g.K, nt = K / BK;
    unsigned voffA[2], voffB[2];
#pragma unroll
    for (int i = 0; i < 2; ++i) { int R, C; stage_rc(tid * 16 + i * 8192, R, C); const int Rb = Epi::PERM ? ((R & ~31) + perm32(R & 31)) : R;
        voffA[i] = (unsigned)(R * K + C) * 2u; voffB[i] = (unsigned)(Rb * K + C) * 2u; }
    const size_t kstep = (size_t)(BK * 2);
    const size_t hstep = (size_t)HALF * K * 2;
    const size_t tstep = 2 * hstep;
    const unsigned ldsw = (unsigned)wid * 1024u;
    const int aoff = lds_byte(wr * 64 + fr, fq * 8), boff = lds_byte(wc * 32 + fr, fq * 8);
#define PG8_SA(b, h) (((b) * 2 + (h)) * HTB)
#define PG8_SB(b, h) ((4 + (b) * 2 + (h)) * HTB)
#define PG8_STAGE(bufoff, gbase, voff) do { _Pragma("unroll") for (int _i = 0; _i < 2; ++_i) \
        __builtin_amdgcn_global_load_lds((const unsigned*)((const char*)(gbase) + (voff)[_i]), (PG8_LAS unsigned*)(lds + (bufoff) + ldsw + _i * 8192), 16, 0, 0); } while (0)
#define PG8_LDA(dst, b, h) do { _Pragma("unroll") for (int m = 0; m < 4; ++m) _Pragma("unroll") for (int k = 0; k < 2; ++k) dst[m][k] = *(const PG8_LAS bf16x8*)(lds + PG8_SA(b, h) + aoff + m * 2048 + k * 1024); } while (0)
#define PG8_LDB(dst, b, h) do { _Pragma("unroll") for (int n = 0; n < 2; ++n) _Pragma("unroll") for (int k = 0; k < 2; ++k) dst[n][k] = *(const PG8_LAS bf16x8*)(lds + PG8_SB(b, h) + boff + n * 2048 + k * 1024); } while (0)
#define PG8_MMA(ai, bj, At, Bt) do { __builtin_amdgcn_s_setprio(1); _Pragma("unroll") for (int m = 0; m < 4; ++m) _Pragma("unroll") for (int n = 0; n < 2; ++n) _Pragma("unroll") for (int k = 0; k < 2; ++k) \
        acc[ai][bj][m][n] = __builtin_amdgcn_mfma_f32_16x16x32_bf16(Bt[n][k], At[m][k], acc[ai][bj][m][n], 0, 0, 0); __builtin_amdgcn_s_setprio(0); } while (0)
#define PG8_WAIT_V(n) asm volatile("s_waitcnt vmcnt(" #n ")" ::: "memory")
#define PG8_WAIT_L(n) asm volatile("s_waitcnt lgkmcnt(" #n ")" ::: "memory")
#define PG8_BAR __builtin_amdgcn_s_barrier()
#define PG8_SCHED __builtin_amdgcn_sched_barrier(0)
    Unit cur, nxt; int ui = 0;
    if (!S.next(0, cur)) return;
    f32x4 acc[2][2][4][2];
#pragma unroll
    for (int a = 0; a < 2; ++a)
#pragma unroll
        for (int b = 0; b < 2; ++b)
#pragma unroll
            for (int m = 0; m < 4; ++m)
#pragma unroll
                for (int n = 0; n < 2; ++n) acc[a][b][m][n] = (f32x4){0.f, 0.f, 0.f, 0.f};
    bf16x8 At[4][2], B0[2][2], B1[2][2];
    const char* cA = (const char*)g.A + (size_t)cur.pm * tstep; const char* cB = (const char*)g.Bt + (size_t)cur.pn * tstep;
    S.a_ready(cur);
    if constexpr (SP2) {
        PG8_STAGE(PG8_SB(0, 0), cB, voffB); PG8_STAGE(PG8_SB(0, 1), cB + hstep, voffB); PG8_STAGE(PG8_SA(0, 0), cA, voffA); PG8_STAGE(PG8_SA(0, 1), cA + hstep, voffA);
        if (wr == 1) PG8_BAR;
        PG8_WAIT_V(2); PG8_BAR;
        PG8_STAGE(PG8_SB(1, 0), cB + kstep, voffB); PG8_STAGE(PG8_SA(1, 0), cA + kstep, voffA); PG8_STAGE(PG8_SB(1, 1), cB + hstep + kstep, voffB);
        PG8_WAIT_V(6); PG8_BAR;
    } else {
        PG8_STAGE(PG8_SB(0, 0), cB, voffB); PG8_STAGE(PG8_SA(0, 0), cA, voffA); PG8_STAGE(PG8_SB(0, 1), cB + hstep, voffB); PG8_STAGE(PG8_SA(0, 1), cA + hstep, voffA);
        if (wr == 1) PG8_BAR;
        PG8_WAIT_V(4); PG8_BAR;
        PG8_STAGE(PG8_SB(1, 0), cB + kstep, voffB); PG8_STAGE(PG8_SA(1, 0), cA + kstep, voffA); PG8_STAGE(PG8_SB(1, 1), cB + hstep + kstep, voffB);
        PG8_WAIT_V(6); PG8_BAR;
    }
    for (;;) {
        const bool has_next = S.next(ui + 1, nxt);
        const char* nA = has_next ? (const char*)g.A + (size_t)nxt.pm * tstep : cA; const char* nB = has_next ? (const char*)g.Bt + (size_t)nxt.pn * tstep : cB;
        for (int t = 0; t < nt; t += 2) {
            const bool last = (t == nt - 2);
            const char* a1 = cA + (size_t)(t + 1) * kstep;
            const char* a2 = last ? nA : cA + (size_t)(t + 2) * kstep; const char* b2 = last ? nB : cB + (size_t)(t + 2) * kstep;
            const char* a3 = a2 + kstep; const char* b3 = b2 + kstep;
            if (last && has_next) S.a_ready(nxt);
            if constexpr (SP2) {
            PG8_LDB(B0, 0, 0); PG8_LDB(B1, 0, 1); PG8_SCHED; PG8_LDA(At, 0, 0); PG8_STAGE(PG8_SA(1, 1), a1 + hstep, voffA);
            PG8_WAIT_V(8); PG8_WAIT_L(0); PG8_BAR; PG8_MMA(0, 0, At, B0); PG8_MMA(0, 1, At, B1); PG8_BAR; PG8_SCHED;
            PG8_LDA(At, 0, 1); PG8_STAGE(PG8_SB(0, 0), b2, voffB); PG8_STAGE(PG8_SB(0, 1), b2 + hstep, voffB); PG8_STAGE(PG8_SA(0, 0), a2, voffA);
            PG8_WAIT_V(8); PG8_WAIT_L(0); PG8_BAR; PG8_MMA(1, 0, At, B0); PG8_MMA(1, 1, At, B1); PG8_BAR; PG8_SCHED;
            PG8_LDB(B0, 1, 0); PG8_LDB(B1, 1, 1); PG8_SCHED; PG8_LDA(At, 1, 0); PG8_STAGE(PG8_SA(0, 1), a2 + hstep, voffA);
            PG8_WAIT_V(8); PG8_WAIT_L(0); PG8_BAR; PG8_MMA(0, 0, At, B0); PG8_MMA(0, 1, At, B1); PG8_BAR; PG8_SCHED;
            PG8_LDA(At, 1, 1); PG8_STAGE(PG8_SB(1, 0), b3, voffB); PG8_STAGE(PG8_SB(1, 1), b3 + hstep, voffB); PG8_STAGE(PG8_SA(1, 0), a3, voffA);
            PG8_WAIT_V(8); PG8_WAIT_L(0); PG8_BAR; PG8_MMA(1, 0, At, B0); PG8_MMA(1, 1, At, B1); PG8_BAR; PG8_SCHED;
            } else {
            PG8_LDB(B0, 0, 0); PG8_SCHED; PG8_LDA(At, 0, 0); PG8_STAGE(PG8_SA(1, 1), a1 + hstep, voffA);
            PG8_WAIT_L(8); PG8_BAR; PG8_WAIT_L(0); PG8_MMA(0, 0, At, B0); PG8_BAR; PG8_SCHED;
            PG8_LDB(B1, 0, 1); PG8_STAGE(PG8_SB(0, 0), b2, voffB);
            PG8_BAR; PG8_WAIT_L(0); PG8_MMA(0, 1, At, B1); PG8_BAR;
            PG8_LDA(At, 0, 1); PG8_STAGE(PG8_SA(0, 0), a2, voffA);
            PG8_BAR; PG8_WAIT_L(0); PG8_MMA(1, 0, At, B0); PG8_BAR; PG8_SCHED;
            PG8_STAGE(PG8_SB(0, 1), b2 + hstep, voffB);
            PG8_WAIT_V(6); PG8_BAR; PG8_MMA(1, 1, At, B1); PG8_BAR;
            PG8_LDB(B0, 1, 0); PG8_SCHED; PG8_LDA(At, 1, 0); PG8_STAGE(PG8_SA(0, 1), a2 + hstep, voffA);
            PG8_WAIT_L(8); PG8_BAR; PG8_WAIT_L(0); PG8_MMA(0, 0, At, B0); PG8_BAR; PG8_SCHED;
            PG8_LDB(B1, 1, 1); PG8_STAGE(PG8_SB(1, 0), b3, voffB);
            PG8_BAR; PG8_WAIT_L(0); PG8_MMA(0, 1, At, B1); PG8_BAR;
            PG8_LDA(At, 1, 1); PG8_STAGE(PG8_SA(1, 0), a3, voffA);
            PG8_BAR; PG8_WAIT_L(0); PG8_MMA(1, 0, At, B0); PG8_BAR; PG8_SCHED;
            PG8_STAGE(PG8_SB(1, 1), b3 + hstep, voffB);
            PG8_WAIT_V(6); PG8_BAR; PG8_MMA(1, 1, At, B1); PG8_BAR;
            }
        }
        if constexpr (ALIGN_EPI) { if (wr == 0) PG8_BAR; }
        if constexpr (!Epi::AFTER_DRAIN) { E(acc, cur, wr, wc, fr, fq); S.done(cur); }
        if (!has_next) break;
#pragma unroll
        for (int a = 0; a < 2; ++a)
#pragma unroll
            for (int b = 0; b < 2; ++b)
#pragma unroll
                for (int m = 0; m < 4; ++m)
#pragma unroll
                    for (int n = 0; n < 2; ++n) acc[a][b][m][n] = (f32x4){0.f, 0.f, 0.f, 0.f};
        cur = nxt; cA = nA; cB = nB; ++ui;
        if constexpr (ALIGN_EPI) { if (wr == 1) PG8_BAR; }
    }
    PG8_WAIT_V(0);
    if constexpr (!ALIGN_EPI) { if (wr == 0) PG8_BAR; }
    PG8_BAR;
    if constexpr (Epi::AFTER_DRAIN) { E.fused(acc, cur, wr, wc, fr, fq, lds, wid, lane); S.done(cur); }
#undef PG8_SA
#undef PG8_SB
#undef PG8_STAGE
#undef PG8_LDA
#undef PG8_LDB
#undef PG8_MMA
#undef PG8_WAIT_V
#undef PG8_WAIT_L
#undef PG8_BAR
#undef PG8_SCHED
}
}
using pg8::bf16_t; using pg8::bf16x8; using pg8::f32x4; using pg8::u32x4;
#define LAS __attribute__((address_space(3)))
typedef unsigned u32x2 __attribute__((ext_vector_type(2)));
typedef float f32x2 __attribute__((ext_vector_type(2)));

constexpr int MROWS = 32768, DM = 1024, TSEQ = 4096, DFF = 2816, NUP = 5632, GLA_IN = 3088, NGLA = 3584;
constexpr int MH = MROWS / 2;
constexpr float EPS = 1e-6f;
constexpr size_t MiB = 1u << 20;
constexpr size_t WS_BAR = 65536;
constexpr size_t WS_LB = 0;
constexpr size_t WS_SSQ = 1 * MiB;
constexpr size_t WS_WT_HG_IN = 2 * MiB, WS_WT_HG_OUT = 10 * MiB, WS_WT_GLA_IN = 12 * MiB, WS_WT_GLA_OUT = 19 * MiB;
constexpr size_t WS_WT_UP0 = 21 * MiB, WS_WT_UP1 = 32 * MiB, WS_WT_DN0 = 43 * MiB, WS_WT_DN1 = 49 * MiB;
constexpr size_t WS_Y = 56 * MiB;
constexpr size_t WS_P = 120 * MiB;
constexpr size_t WS_ORAW = 440 * MiB;
constexpr size_t WS_ACT = 120 * MiB;
constexpr size_t WS_HALO = 300 * MiB;
constexpr size_t WS_END = 504 * MiB;
constexpr int XB_LDS_OFF = 150528;
constexpr int LDS_BYTES = 151552;

__device__ __forceinline__ unsigned f2bf(float f) { unsigned u = __builtin_bit_cast(unsigned, f); return (u + 0x7fffu + ((u >> 16) & 1u)) >> 16; }
__device__ __forceinline__ unsigned pk2(float lo, float hi) { return pg8::cvt_pk_bf16(lo, hi); }
__device__ __forceinline__ float bflo(unsigned w) { return __builtin_bit_cast(float, w << 16); }
__device__ __forceinline__ float bfhi(unsigned w) { return __builtin_bit_cast(float, w & 0xffff0000u); }
__device__ __forceinline__ float wave_sum(float v) {
#pragma unroll
    for (int o = 1; o < 64; o <<= 1) v += __shfl_xor(v, o);
    return v;
}

struct Args { const float* in[17]; float* out; unsigned char* ws; };

__device__ __forceinline__ void p0_transpose_item64(const float* W, int K, int ldw, int nblk2, bf16_t* WT, LAS float* scr, int item, int lane, const float* rsc = nullptr, bool glu_perm = false, bool ntst = false) {
    const int kb = item / nblk2, nb = item % nblk2, k0 = 64 * kb, n0 = 64 * nb;
    float v0[32], v1[32];
#pragma unroll
    for (int i = 0; i < 32; ++i) { const size_t ro = (size_t)(k0 + 2 * i + (lane >> 5)) * ldw + n0 + (lane & 31); v0[i] = __builtin_nontemporal_load(W + ro); v1[i] = __builtin_nontemporal_load(W + ro + 32); }
    if (rsc) {
#pragma unroll
        for (int i = 0; i < 32; ++i) { const float r = rsc[k0 + 2 * i + (lane >> 5)]; v0[i] *= r; v1[i] *= r; } }
#pragma unroll
    for (int h = 0; h < 2; ++h) {
#pragma unroll
        for (int i = 0; i < 32; ++i) scr[(2 * i + (lane >> 5)) * 33 + (lane & 31)] = h ? v1[i] : v0[i];
        asm volatile("s_waitcnt lgkmcnt(0)" ::: "memory");
        const int c = lane & 7;
#pragma unroll
        for (int j = 0; j < 4; ++j) { const int n = (lane >> 3) + 8 * j; const LAS float* s = scr + (8 * c) * 33 + n;
            u32x4 o; o.x = pk2(s[0 * 33], s[1 * 33]); o.y = pk2(s[2 * 33], s[3 * 33]); o.z = pk2(s[4 * 33], s[5 * 33]); o.w = pk2(s[6 * 33], s[7 * 33]);
            int drow = n0 + 32 * h + n; if (glu_perm) { const int half = drow >= DFF ? 1 : 0, cc = drow - half * DFF; drow = 256 * (cc >> 7) + 128 * half + (cc & 127); }
            if (ntst) __builtin_nontemporal_store(o, (u32x4*)(WT + (size_t)drow * K + k0 + 8 * c)); else *(u32x4*)(WT + (size_t)drow * K + k0 + 8 * c) = o; }
        asm volatile("s_waitcnt lgkmcnt(0)" ::: "memory");
    }
}

__device__ __forceinline__ void rms_phase(const float* x, const float* w, bf16_t* y, int gw, int ngw, int lane) {
    constexpr int R = 4;
    const f32x4* wr = (const f32x4*)w + lane;
    for (int m = gw; m < MROWS; m += R * ngw) {
        f32x4 v[R][4]; float s[R];
#pragma unroll
        for (int r = 0; r < R; ++r) { const int mr = (m + r * ngw < MROWS) ? m + r * ngw : m; const f32x4* xa = (const f32x4*)(x + (size_t)mr * DM) + lane;
#pragma unroll
            for (int j = 0; j < 4; ++j) v[r][j] = __builtin_nontemporal_load(xa + 64 * j); }
#pragma unroll
        for (int r = 0; r < R; ++r) { float a = 0.f;
#pragma unroll
            for (int j = 0; j < 4; ++j) a += (v[r][j].x * v[r][j].x + v[r][j].y * v[r][j].y) + (v[r][j].z * v[r][j].z + v[r][j].w * v[r][j].w);
            s[r] = 1.0f / sqrtf(wave_sum(a) * (1.f / DM) + EPS); }
#pragma unroll
        for (int r = 0; r < R; ++r) { const int mr = (m + r * ngw < MROWS) ? m + r * ngw : m; u32x2* oa = (u32x2*)(y + (size_t)mr * DM) + lane;
#pragma unroll
            for (int j = 0; j < 4; ++j) { const f32x4 ww = wr[64 * j]; u32x2 o;
                o.x = pk2(v[r][j].x * s[r] * ww.x, v[r][j].y * s[r] * ww.y); o.y = pk2(v[r][j].z * s[r] * ww.z, v[r][j].w * s[r] * ww.w); oa[64 * j] = o; } }
    }
}

__device__ __forceinline__ void rms_final_bf16_phase(const bf16_t* hb, const unsigned long long* ssq, const float* w, float* out, int gw, int ngw, int lane) {
    constexpr int R = 4;
    const f32x4* wr = (const f32x4*)w + 2 * lane;
    for (int m = gw; m < MROWS; m += R * ngw) {
        u32x4 v[R][2]; float rs[R];
#pragma unroll
        for (int r = 0; r < R; ++r) { const int mr = (m + r * ngw < MROWS) ? m + r * ngw : m;
#pragma unroll
            for (int j = 0; j < 2; ++j) v[r][j] = __builtin_nontemporal_load((const u32x4*)(hb + (size_t)mr * DM + 512 * j + 8 * lane));
            rs[r] = 1.0f / sqrtf(pg8::row_ssq16(ssq, mr) * (1.f / DM) + EPS); }
#pragma unroll
        for (int r = 0; r < R; ++r) { if (r && m + r * ngw >= MROWS) continue; const int mr = m + r * ngw;
#pragma unroll
            for (int j = 0; j < 2; ++j) { const f32x4 w0 = wr[128 * j], w1 = wr[128 * j + 1]; f32x4* oa = (f32x4*)(out + (size_t)mr * DM + 512 * j + 8 * lane);
                __builtin_nontemporal_store((f32x4){bflo(v[r][j].x), bfhi(v[r][j].x), bflo(v[r][j].y), bfhi(v[r][j].y)} * rs[r] * w0, oa); __builtin_nontemporal_store((f32x4){bflo(v[r][j].z), bfhi(v[r][j].z), bflo(v[r][j].w), bfhi(v[r][j].w)} * rs[r] * w1, oa + 1); } }
    }
}

__device__ __forceinline__ void glu_fixup_phase(const bf16_t* HALO, bf16_t* ACT, const float* cw, const float* cb, int gtid, int ngt) {
    constexpr int CG = DFF / 8, NG = MROWS / 64, NITEM = NG * CG;
    for (int it = gtid; it < NITEM; it += ngt) {
        const int cgp = it % CG, gg = it / CG, c0 = cgp * 8;
        const bool seq_start = ((gg * 64) % TSEQ) == 0;
        float um2[2][8], um1[2][8], u0[2][8], u1[2][8];
#pragma unroll
        for (int hf = 0; hf < 2; ++hf) {
            const bf16_t* hc = HALO + (size_t)gg * 4 * NUP + hf * DFF + c0;
            const u32x4 r0 = *(const u32x4*)(hc), r1 = *(const u32x4*)(hc + NUP);
            u32x4 p2 = (u32x4){0u, 0u, 0u, 0u}, p1 = (u32x4){0u, 0u, 0u, 0u};
            if (!seq_start) { const bf16_t* hp = HALO + (size_t)(gg - 1) * 4 * NUP + hf * DFF + c0; p2 = *(const u32x4*)(hp + 2 * NUP); p1 = *(const u32x4*)(hp + 3 * NUP); }
            um2[hf][0] = bflo(p2.x); um2[hf][1] = bfhi(p2.x); um2[hf][2] = bflo(p2.y); um2[hf][3] = bfhi(p2.y); um2[hf][4] = bflo(p2.z); um2[hf][5] = bfhi(p2.z); um2[hf][6] = bflo(p2.w); um2[hf][7] = bfhi(p2.w);
            um1[hf][0] = bflo(p1.x); um1[hf][1] = bfhi(p1.x); um1[hf][2] = bflo(p1.y); um1[hf][3] = bfhi(p1.y); um1[hf][4] = bflo(p1.z); um1[hf][5] = bfhi(p1.z); um1[hf][6] = bflo(p1.w); um1[hf][7] = bfhi(p1.w);
            u0[hf][0] = bflo(r0.x); u0[hf][1] = bfhi(r0.x); u0[hf][2] = bflo(r0.y); u0[hf][3] = bfhi(r0.y); u0[hf][4] = bflo(r0.z); u0[hf][5] = bfhi(r0.z); u0[hf][6] = bflo(r0.w); u0[hf][7] = bfhi(r0.w);
            u1[hf][0] = bflo(r1.x); u1[hf][1] = bfhi(r1.x); u1[hf][2] = bflo(r1.y); u1[hf][3] = bfhi(r1.y); u1[hf][4] = bflo(r1.z); u1[hf][5] = bfhi(r1.z); u1[hf][6] = bflo(r1.w); u1[hf][7] = bfhi(r1.w);
        }
        float o0[8], o1[8];
#pragma unroll
        for (int e = 0; e < 8; ++e) { const int ch = c0 + e;
            const float wa0 = cw[ch], wa1 = cw[NUP + ch], wa2 = cw[2 * NUP + ch], ba = cb[ch];
            const float wg0 = cw[DFF + ch], wg1 = cw[NUP + DFF + ch], wg2 = cw[2 * NUP + DFF + ch], bg = cb[DFF + ch];
            const float a0 = ba + wa0 * um2[0][e] + wa1 * um1[0][e] + wa2 * u0[0][e], g0 = bg + wg0 * um2[1][e] + wg1 * um1[1][e] + wg2 * u0[1][e];
            const float a1 = ba + wa0 * um1[0][e] + wa1 * u0[0][e] + wa2 * u1[0][e], g1 = bg + wg0 * um1[1][e] + wg1 * u0[1][e] + wg2 * u1[1][e];
            o0[e] = pg8::fsilu(g0) * a0; o1[e] = pg8::fsilu(g1) * a1; }
        u32x4 w0, w1; w0.x = pk2(o0[0], o0[1]); w0.y = pk2(o0[2], o0[3]); w0.z = pk2(o0[4], o0[5]); w0.w = pk2(o0[6], o0[7]);
        w1.x = pk2(o1[0], o1[1]); w1.y = pk2(o1[2], o1[3]); w1.z = pk2(o1[4], o1[5]); w1.w = pk2(o1[6], o1[7]);
        *(u32x4*)(ACT + (size_t)(gg * 64) * DFF + c0) = w0; *(u32x4*)(ACT + (size_t)(gg * 64 + 1) * DFF + c0) = w1;
    }
}

#define XB_TMO      128
#define XB_XCNT(j)  (256  + 64 * (j))
#define XB_XSUB(j)  (1280 + 64 * (j))
#define XB_XGEN(j)  (2304 + 64 * (j))
#define XB_TOP      3328
#define XB_TOPGEN   3392
#define XCD_BAR_WORDS 3456
#define XB_SPIN_CAP (1u << 18)

__device__ __forceinline__ unsigned xb_ld(unsigned* p)              { return __hip_atomic_load(p, __ATOMIC_RELAXED, __HIP_MEMORY_SCOPE_AGENT); }
__device__ __forceinline__ unsigned xb_add(unsigned* p, unsigned v) { return __hip_atomic_fetch_add(p, v, __ATOMIC_RELAXED, __HIP_MEMORY_SCOPE_AGENT); }
__device__ __forceinline__ unsigned xb_xcc_id() { return (unsigned)__builtin_amdgcn_s_getreg((3 << 11) | 20) & 0xFu; }
#define XB_SPIN(cond, bar) do { unsigned _sp = 0; while (cond) { __builtin_amdgcn_s_sleep(1); \
    if ((++_sp & 255u) == 0u) { if (xb_ld(&(bar)[XB_TMO])) break; if (_sp > XB_SPIN_CAP) { atomicAdd(&(bar)[XB_TMO], 1u); break; } } } } while (0)

struct XcdBarrier {
    unsigned* bar; unsigned x;
    volatile LAS unsigned* st;
};

__device__ __forceinline__ XcdBarrier xcd_barrier_post(unsigned* bar, volatile LAS unsigned* st) {
    XcdBarrier b; b.bar = bar; b.x = xb_xcc_id(); b.st = st;
    if (threadIdx.x == 0) st[2] = xb_add(&bar[XB_XCNT(b.x)], 1u);
    return b;
}
__device__ __forceinline__ void xcd_barrier_complete(unsigned* bar, unsigned x, unsigned& nloc, unsigned& nx) {
    const unsigned G = gridDim.x * gridDim.y * gridDim.z;
    unsigned sum, cnt, mine, sp = 0u;
    for (;;) {
        sum = 0u; cnt = 0u; mine = 0u;
#pragma unroll
        for (unsigned j = 0; j < 16; ++j) { const unsigned c = xb_ld(&bar[XB_XCNT(j)]); sum += c; cnt += (c > 0u) ? 1u : 0u; mine = (j == x) ? c : mine; }
        if (sum == G) break;
        __builtin_amdgcn_s_sleep(1);
        if ((++sp & 255u) == 0u) { if (xb_ld(&bar[XB_TMO])) break; if (sp > XB_SPIN_CAP) { atomicAdd(&bar[XB_TMO], 1u); break; } }
    }
    nloc = mine > 0u ? mine : 1u; nx = cnt > 0u ? cnt : 1u;
}

__device__ __forceinline__ void xcd_barrier(const XcdBarrier& b) {
    asm volatile("s_waitcnt vmcnt(0)" ::: "memory");
    __syncthreads();
    if (threadIdx.x == 0) {
        unsigned* bar = b.bar;
        __builtin_amdgcn_s_waitcnt(0);
        unsigned nloc = b.st[0], nx = b.st[1];
        if (nloc == 0u) { xcd_barrier_complete(bar, b.x, nloc, nx); b.st[0] = nloc; b.st[1] = nx; }
        const unsigned old = xb_add(&bar[XB_XSUB(b.x)], 1u);
        const unsigned gen = old / nloc;
        if (old + 1u == (gen + 1u) * nloc) {
            __builtin_amdgcn_fence(__ATOMIC_RELEASE, "agent");
            asm volatile("s_waitcnt vmcnt(0)" ::: "memory");
            const unsigned og = xb_add(&bar[XB_TOP], 1u);
            const unsigned tg = og / nx;
            if (og + 1u == (tg + 1u) * nx) xb_add(&bar[XB_TOPGEN], 1u);
            else XB_SPIN(xb_ld(&bar[XB_TOPGEN]) == tg, bar);
            __builtin_amdgcn_fence(__ATOMIC_ACQUIRE, "agent");
            xb_add(&bar[XB_XGEN(b.x)], 1u);
            asm volatile("s_waitcnt vmcnt(0)" ::: "memory");
        } else {
            XB_SPIN(xb_ld(&bar[XB_XGEN(b.x)]) == gen, bar);
            __builtin_amdgcn_fence(__ATOMIC_ACQUIRE, "agent");
            asm volatile("s_waitcnt vmcnt(0)" ::: "memory");
        }
    }
    __syncthreads();
}
__device__ __forceinline__ int offb(int row, int ch) { return 256 * row + 16 * (ch ^ (((row & 3) << 2) | ((row >> 2) & 3))); }
typedef short s16x4 __attribute__((ext_vector_type(4)));
__device__ __forceinline__ int tr_lane_const(int fr, int fq) { const int q = fr >> 2, p = fr & 3; return 256 * (8 * fq + q) + 8 * (p & 1) + 16 * ((((q << 2) | ((2 * fq) & 3))) ^ (p >> 1)); }
__device__ __forceinline__ bf16x8 tr_frag(LAS unsigned char* lds, int imgoff, int c, int ks, int LX) {
    const s16x4 a = __builtin_amdgcn_ds_read_tr16_b64_v4i16((LAS s16x4*)(lds + (imgoff + 8192 * ks) + (LX ^ (32 * c))));
    const s16x4 b = __builtin_amdgcn_ds_read_tr16_b64_v4i16((LAS s16x4*)(lds + (imgoff + 8192 * ks + 1024) + ((LX ^ 16) ^ (32 * c))));
    return __builtin_shufflevector(a, b, 0, 1, 2, 3, 4, 5, 6, 7);
}
constexpr int PQ = 272, PS = 144;
#define SCAN_BAR() do { asm volatile("s_waitcnt lgkmcnt(0)" ::: "memory"); __builtin_amdgcn_s_barrier(); asm volatile("" ::: "memory"); } while (0)
#define MFMA16(a, b, c) __builtin_amdgcn_mfma_f32_16x16x32_bf16((a), (b), (c), 0, 0, 0)
constexpr int SCAN_LDS_MAX = 150528;

template <int LDQK, int HEADS, int PASS>
__device__ __forceinline__ void scan_phase(LAS unsigned char* lds, const bf16_t* Q, const bf16_t* K, const bf16_t* G, const bf16_t* V, bf16_t* O, float* SLOC, float* DSEG, const bf16_t* GATE, const float* nw, int bx, int nblk) {
    int tid_ = threadIdx.x; asm volatile("" : "+v"(tid_)); const int tid = tid_, lane = tid & 63, w = __builtin_amdgcn_readfirstlane(tid >> 6);
    const int fr = lane & 15, fq = lane >> 4, tb = w >> 1, vh = w & 1, LX = tr_lane_const(fr, fq);
    constexpr int DVH = 1024 / HEADS, NX = DVH / 16, NXH = NX / 2, NSEG = 256 / (8 * HEADS), CPS = 64 / NSEG, NVP = NX / 4, CPR = 2 * NX  , RPP = 512 / CPR  ;
    constexpr int SC_QB = 0, SC_KT = 17408, SC_V = 33792, SC_P = SC_V + 4096 * NVP * 2, SC_ST = SC_P + 9216, SC_SEG = SC_ST + 16 * NX * PQ, SC_EBL = SC_SEG + 4096, SC_NRM = SC_EBL + 512;
    static_assert(SC_NRM + 512 <= SCAN_LDS_MAX, "scan LDS map");
    constexpr bool GFROMK = (HEADS == 8);
    for (int u = bx; u < 256; u += nblk) {
        const int seg = u % NSEG, seq = u / NSEG;
        if (PASS == 1 && seg == NSEG - 1) continue;
        const int b = seq / HEADS, h = seq % HEADS;
        const size_t row0 = (size_t)b * TSEQ + (size_t)seg * CPS * 64;
        const int voff = h * DVH;
        const bf16_t* qp = Q + row0 * LDQK + h * 128; const bf16_t* kp = K + row0 * LDQK + h * 128; const bf16_t* gp = G + row0 * LDQK + h * 128;
        const bf16_t* vp = V + row0 * 1024 + voff; bf16_t* op = O + row0 * 1024 + voff; const bf16_t* gtp = GATE + row0 * 1024 + voff;
        const unsigned lqk = 2u * (unsigned)lane, lv = (unsigned)(tid / CPR) * 1024u + 8u * (unsigned)(tid % CPR), lo = (unsigned)(16 * tb + fr) * 1024u + (unsigned)(16 * NXH * vh + 4 * fq);
        f32x4 S[NX];
#pragma unroll
        for (int x = 0; x < NX; ++x) S[x] = (f32x4){0.f, 0.f, 0.f, 0.f};
        f32x4 dacc = (f32x4){1.f, 1.f, 1.f, 1.f};
        if (PASS == 3) {
            f32x4 pw[NSEG - 1]; f32x4 run = (f32x4){1.f, 1.f, 1.f, 1.f};
#pragma unroll
            for (int sp = NSEG - 2; sp >= 0; --sp) { pw[sp] = run; if (sp < seg) run = run * *(const f32x4*)(DSEG + (size_t)(u - seg + sp) * 128 + 16 * w + 4 * fq); }
#pragma unroll
            for (int x = 0; x < NX; ++x) {
#pragma unroll
                for (int sp = 0; sp < NSEG - 1; ++sp) if (sp < seg) { const f32x4 sl = *(const f32x4*)(SLOC + (((size_t)(u - seg + sp) * 8 + w) * NX + x) * 256 + lane * 4); S[x] = S[x] + pw[sp] * sl; } }
        }
        unsigned rg[8], rq[8], rk[8]; u32x4 rvv[NVP];
#pragma unroll
        for (int i = 0; i < 8; ++i) { const size_t ro = (size_t)(8 * w + i) * LDQK; if (!GFROMK) rg[i] = *(const unsigned*)(gp + ro + lqk); rk[i] = *(const unsigned*)(kp + ro + lqk); if (PASS == 3) rq[i] = *(const unsigned*)(qp + ro + lqk); }
        constexpr bool VPRE = (NX <= 8) || (PASS == 1);
        if (VPRE) {
#pragma unroll
            for (int j = 0; j < NVP; ++j) rvv[j] = *(const u32x4*)(vp + (size_t)(RPP * j) * 1024 + lv); }
        for (int n = 0; n < CPS; ++n) {
            if (!VPRE) {
#pragma unroll
                for (int j = 0; j < NVP; ++j) rvv[j] = *(const u32x4*)(vp + (size_t)(n * 64 + RPP * j) * 1024 + lv); }
            float c0[8], c1[8]; float a0 = 0.f, a1 = 0.f;
#pragma unroll
            for (int i = 0; i < 8; ++i) { if (GFROMK) { a0 += __log2f(1.0f - bflo(rk[i])); a1 += __log2f(1.0f - bfhi(rk[i])); } else { a0 += bflo(rg[i]); a1 += bfhi(rg[i]); } c0[i] = a0; c1[i] = a1; }
            *(LAS f32x2*)(lds + SC_SEG + w * 512 + lane * 8) = (f32x2){a0, a1};
            SCAN_BAR();
            float off0 = 0.f, off1 = 0.f, tot0 = 0.f, tot1 = 0.f;
#pragma unroll
            for (int ww = 0; ww < 8; ++ww) { const f32x2 s = *(const LAS f32x2*)(lds + SC_SEG + ww * 512 + lane * 8); if (ww < w) { off0 += s.x; off1 += s.y; } tot0 += s.x; tot1 += s.y; }
            if (w == 0) *(LAS f32x2*)(lds + SC_EBL + lane * 8) = (f32x2){__builtin_amdgcn_exp2f(tot0), __builtin_amdgcn_exp2f(tot1)};
#pragma unroll
            for (int i = 0; i < 8; ++i) {
                const float b0 = off0 + c0[i], b1 = off1 + c1[i];
                const float i0 = __builtin_amdgcn_exp2f(-b0), i1 = __builtin_amdgcn_exp2f(-b1);
                *(LAS unsigned*)(lds + SC_KT + offb(8 * w + i, lane >> 2) + 4 * (lane & 3)) = pk2(bflo(rk[i]) * i0, bfhi(rk[i]) * i1);
                if (PASS == 3) { const float e0 = __builtin_amdgcn_exp2f(b0), e1 = __builtin_amdgcn_exp2f(b1);
                    *(LAS unsigned*)(lds + SC_QB + (8 * w + i) * PQ + lane * 4) = pk2(bflo(rq[i]) * e0, bfhi(rq[i]) * e1); }
            }
#pragma unroll
            for (int j = 0; j < NVP; ++j) { const int c8 = tid % CPR; *(LAS u32x4*)(lds + SC_V + (c8 >> 4) * 16384 + offb(tid / CPR + RPP * j, c8 & 15)) = rvv[j]; }
            if (PASS == 3) {
#pragma unroll
                for (int x = 0; x < NX; ++x) { u32x2 sv; sv.x = pk2(S[x][0], S[x][1]); sv.y = pk2(S[x][2], S[x][3]);
                    *(LAS u32x2*)(lds + SC_ST + (16 * x + fr) * PQ + (16 * w + 4 * fq) * 2) = sv; } }
            SCAN_BAR();
            if (n + 1 < CPS) {
#pragma unroll
                for (int i = 0; i < 8; ++i) { const size_t ro = (size_t)((n + 1) * 64 + 8 * w + i) * LDQK; if (!GFROMK) rg[i] = *(const unsigned*)(gp + ro + lqk); rk[i] = *(const unsigned*)(kp + ro + lqk); if (PASS == 3) rq[i] = *(const unsigned*)(qp + ro + lqk); }
                if (VPRE) {
#pragma unroll
                    for (int j = 0; j < NVP; ++j) rvv[j] = *(const u32x4*)(vp + (size_t)((n + 1) * 64 + RPP * j) * 1024 + lv); }
            }
            if (PASS == 3) {
                f32x4 oacc[NXH];
                bf16x8 qf[4];
#pragma unroll
                for (int ks = 0; ks < 4; ++ks) qf[ks] = *(const LAS bf16x8*)(lds + SC_QB + (16 * tb + fr) * PQ + (32 * ks + 8 * fq) * 2);
#pragma unroll
                for (int xx = 0; xx < NXH; ++xx) { oacc[xx] = (f32x4){0.f, 0.f, 0.f, 0.f};
#pragma unroll
                    for (int ks = 0; ks < 4; ++ks) { const bf16x8 sf = *(const LAS bf16x8*)(lds + SC_ST + (16 * (NXH * vh + xx) + fr) * PQ + (32 * ks + 8 * fq) * 2); oacc[xx] = MFMA16(sf, qf[ks], oacc[xx]); }
                    if ((xx & 1) == 1) __builtin_amdgcn_sched_barrier(0); }
#pragma unroll
                for (int e = 0; e < 2; ++e) { const int sb = 2 * vh + e;
                    f32x4 pacc = (f32x4){0.f, 0.f, 0.f, 0.f};
                    if (sb <= tb) {
#pragma unroll
                        for (int ks = 0; ks < 4; ++ks) { const bf16x8 kf = *(const LAS bf16x8*)(lds + SC_KT + offb(16 * sb + fr, 4 * ks + fq)); pacc = MFMA16(kf, qf[ks], pacc); }
                        if (sb == tb) {
#pragma unroll
                            for (int j = 0; j < 4; ++j) if (4 * fq + j > fr) pacc[j] = 0.f; }
                    }
                    u32x2 pv; pv.x = pk2(pacc[0], pacc[1]); pv.y = pk2(pacc[2], pacc[3]);
                    *(LAS u32x2*)(lds + SC_P + (16 * tb + fr) * PS + (16 * sb + 4 * fq) * 2) = pv; }
                SCAN_BAR();
                u32x2 gt[NXH];
#pragma unroll
                for (int xx = 0; xx < NXH; ++xx) gt[xx] = *(const u32x2*)(gtp + (size_t)(n * 64) * 1024 + 16 * xx + lo);
#pragma unroll
                for (int ks = 0; ks < 2; ++ks) { if (ks == 1 && tb < 2) continue;
                    const bf16x8 pf = *(const LAS bf16x8*)(lds + SC_P + (16 * tb + fr) * PS + (32 * ks + 8 * fq) * 2);
#pragma unroll
                    for (int xx = 0; xx < NXH; ++xx) { const int c = NXH * vh + xx; const bf16x8 vf = tr_frag(lds, SC_V + (c >> 3) * 16384, c & 7, ks, LX); oacc[xx] = MFMA16(vf, pf, oacc[xx]);
                        if ((xx & 3) == 3) __builtin_amdgcn_sched_barrier(0); } }
                float part = 0.f;
#pragma unroll
                for (int xx = 0; xx < NXH; ++xx) part += (oacc[xx][0] * oacc[xx][0] + oacc[xx][1] * oacc[xx][1]) + (oacc[xx][2] * oacc[xx][2] + oacc[xx][3] * oacc[xx][3]);
                part += __shfl_xor(part, 16); part += __shfl_xor(part, 32);
                if (fq == 0) *(LAS float*)(lds + SC_NRM + ((tb * 2 + vh) * 16 + fr) * 4) = part;
                SCAN_BAR();
                const float ssq = *(const LAS float*)(lds + SC_NRM + ((tb * 2) * 16 + fr) * 4) + *(const LAS float*)(lds + SC_NRM + ((tb * 2 + 1) * 16 + fr) * 4);
                const float rstd = 1.0f / sqrtf(ssq * (1.0f / DVH) + EPS);
#pragma unroll
                for (int xx = 0; xx < NXH; ++xx) { const f32x4 nwv = *(const f32x4*)(nw + 16 * NXH * vh + 16 * xx + 4 * fq);
                    const float g0 = bflo(gt[xx].x), g1 = bfhi(gt[xx].x), g2 = bflo(gt[xx].y), g3 = bfhi(gt[xx].y);
                    u32x2 ov; ov.x = pk2(oacc[xx][0] * rstd * nwv[0] * pg8::fsilu(g0), oacc[xx][1] * rstd * nwv[1] * pg8::fsilu(g1));
                    ov.y = pk2(oacc[xx][2] * rstd * nwv[2] * pg8::fsilu(g2), oacc[xx][3] * rstd * nwv[3] * pg8::fsilu(g3));
                    *(u32x2*)(op + (size_t)(n * 64) * 1024 + 16 * xx + lo) = ov;
                    if ((xx & 1) == 1) __builtin_amdgcn_sched_barrier(0); }
            }
            const f32x4 ebl = *(const LAS f32x4*)(lds + SC_EBL + (16 * w + 4 * fq) * 4);
            if (PASS == 1) dacc = dacc * ebl;
#pragma unroll
            for (int ks = 0; ks < 2; ++ks) { const bf16x8 af = tr_frag(lds, SC_KT, w, ks, LX);
#pragma unroll
                for (int x = 0; x < NX; ++x) { const bf16x8 bfv = tr_frag(lds, SC_V + (x >> 3) * 16384, x & 7, ks, LX); S[x] = MFMA16(af, bfv, S[x]);
                    if ((x & 3) == 3) __builtin_amdgcn_sched_barrier(0); } }
#pragma unroll
            for (int x = 0; x < NX; ++x) S[x] = S[x] * ebl;
        }
        if (PASS == 1) {
#pragma unroll
            for (int x = 0; x < NX; ++x) *(f32x4*)(SLOC + (((size_t)u * 8 + w) * NX + x) * 256 + lane * 4) = S[x];
            if (fr == 0) *(f32x4*)(DSEG + (size_t)u * 128 + 16 * w + 4 * fq) = dacc;
        }
        SCAN_BAR();
    }
}
constexpr int NPHASE = 14;
__global__ void __launch_bounds__(512, 2) fwd_kernel(Args a, int ph_lo, int ph_hi) {
    extern __shared__ __attribute__((aligned(16))) unsigned char lds_raw[];
    LAS unsigned char* lds = (LAS unsigned char*)lds_raw;
    cg::grid_group grid = cg::this_grid();
    if (threadIdx.x < 4) ((volatile LAS unsigned*)(lds + XB_LDS_OFF))[threadIdx.x] = 0u;
    __syncthreads();
    XcdBarrier xbar = xcd_barrier_post((unsigned*)(a.ws + WS_BAR), (volatile LAS unsigned*)(lds + XB_LDS_OFF));
    const int G = gridDim.x, bx = blockIdx.x;
    unsigned char* ws = a.ws;
    const float* x = a.in[0]; const float* lb_logits = a.in[1]; const float* hg_w_in = a.in[2]; const float* hg_norm_w = a.in[3]; const float* hg_w_out = a.in[4];
    const float* gla_w_in = a.in[5]; const float* gla_w_gk = a.in[6]; const float* gla_b_gk = a.in[7]; const float* gla_norm_w = a.in[8]; const float* gla_w_out = a.in[9];
    const float* norm_mixer_w = a.in[10]; const float* norm_ffn_w = a.in[11]; const float* ffn_w_up = a.in[12]; const float* ffn_conv_w = a.in[13]; const float* ffn_conv_b = a.in[14];
    const float* ffn_w_down = a.in[15]; const float* norm_final_w = a.in[16];
    float* hres = a.out;
    float* LB = (float*)(ws + WS_LB);
    bf16_t* WT_HG_IN = (bf16_t*)(ws + WS_WT_HG_IN); bf16_t* WT_HG_OUT = (bf16_t*)(ws + WS_WT_HG_OUT); bf16_t* WT_GLA_IN = (bf16_t*)(ws + WS_WT_GLA_IN); bf16_t* WT_GLA_OUT = (bf16_t*)(ws + WS_WT_GLA_OUT);
    bf16_t* Y = (bf16_t*)(ws + WS_Y); bf16_t* ORAW = (bf16_t*)(ws + WS_ORAW); bf16_t* ACT = (bf16_t*)(ws + WS_ACT);
    bf16_t* PQ_ = (bf16_t*)(ws + WS_P);
    bf16_t* PK_ = (bf16_t*)(ws + WS_P + 64 * MiB);
    bf16_t* PG_ = (bf16_t*)(ws + WS_P + 128 * MiB);
    bf16_t* PV_ = (bf16_t*)(ws + WS_P + 192 * MiB);
    bf16_t* PGATE = (bf16_t*)(ws + WS_P + 256 * MiB);


    constexpr int I0 = 16 * 64, I1 = 16 * 16, I2 = 16 * 48, I3 = 16 * 16, I4 = 16 * 88, I5 = 44 * 16, NIT = I0 + I1 + I2 + I3 + 2 * I4 + 2 * I5;
#pragma unroll 1
    for (int ph = ph_lo; ph < ph_hi;) {
        int tid_ = threadIdx.x; asm volatile("" : "+v"(tid_)); const int tid = tid_, lane = tid & 63, wave = __builtin_amdgcn_readfirstlane(tid >> 6);
        const int gw = bx * 8 + wave, ngw = G * 8, gtid = bx * 512 + tid, ngt = G * 512;
        int type = 0;
        const bf16_t* gA = Y; const bf16_t* gB = WT_HG_IN; int gM = MROWS, gN = 1024, gK = 1024, kind = 0, L = 0; const float* aux = LB; const float* base = x; float* outp = hres;
        bf16_t* hbp = nullptr; const bf16_t* baseb = nullptr; unsigned long long* ssqp = nullptr; const unsigned long long* rsp = nullptr; int nof32 = 0;
        unsigned long long* SSQ = (unsigned long long*)(ws + WS_SSQ); bf16_t* HALO = (bf16_t*)(ws + WS_HALO);
        bf16_t* HB2 = (bf16_t*)hres;
        int p = ph;
        if (p >= 7) L = 1;
        if (p >= 4 && p < 7) p = p - 4 + 100; else if (p >= 10 && p < 13) p = p - 10 + 100;
        const bf16_t* WTU = (const bf16_t*)(ws + (L == 0 ? WS_WT_UP0 : WS_WT_UP1)); const bf16_t* WTD = (const bf16_t*)(ws + (L == 0 ? WS_WT_DN0 : WS_WT_DN1));
        const float* cwp = ffn_conv_w + (size_t)L * 3 * NUP; const float* cbp = ffn_conv_b + (size_t)L * NUP;
        unsigned long long* ssq_mix = SSQ + (size_t)(L == 0 ? 0 : 2) * MROWS; unsigned long long* ssq_ffn = SSQ + (size_t)1 * MROWS;
        switch (p) {
            case 0: type = 0; break;
            case 1: type = 1; gA = Y; gB = WT_HG_IN; gN = 4096; kind = 0; aux = LB; break;
            case 2: type = 3; break;
            case 3: type = 2; gA = Y; gB = WT_HG_OUT; base = x; outp = hres; hbp = ORAW; ssqp = ssq_mix; nof32 = 1; break;
            case 7: type = 1; gA = HB2; gB = WT_GLA_IN; gN = NGLA; kind = 1; aux = gla_b_gk; rsp = ssq_ffn; break;
            case 8: type = 3; break;
            case 9: type = 2; gA = Y; gB = WT_GLA_OUT; base = hres; baseb = HB2; outp = hres; hbp = ORAW; ssqp = ssq_mix; nof32 = 1; break;
            case 13: type = 7; break;
            case 100: type = 1; gA = ORAW; gB = WTU; gN = NUP; kind = 3; rsp = ssq_mix; break;
            case 101: type = 6; break;
            default: type = 2; gA = ACT; gB = WTD; gK = DFF; base = hres; baseb = ORAW; outp = hres; hbp = (L == 0) ? HB2 : Y; ssqp = (L == 0) ? ssq_ffn : SSQ + (size_t)3 * MROWS; nof32 = 1; break;
        }
        if (type == 0) {
            for (int e = gtid; e < 4 * MROWS; e += ngt) SSQ[e] = 0ull;
            LAS float* scr = (LAS float*)(lds + wave * 16384);
            for (int it = gw; it < NIT; it += ngw) {
                int r = it;
                if (r < I0) { p0_transpose_item64(hg_w_in, 1024, 4096, 64, WT_HG_IN, scr, r, lane); continue; } r -= I0;
                if (r < I1) { p0_transpose_item64(hg_w_out, 1024, 1024, 16, WT_HG_OUT, scr, r, lane, nullptr, false, true); continue; } r -= I1;
                if (r < I2) { p0_transpose_item64(gla_w_in, 1024, GLA_IN, 48, WT_GLA_IN, scr, r, lane, norm_mixer_w + 1024, false, true); continue; } r -= I2;
                if (r < I3) { p0_transpose_item64(gla_w_out, 1024, 1024, 16, WT_GLA_OUT, scr, r, lane, nullptr, false, true); continue; } r -= I3;
                if (r < I4) { p0_transpose_item64(ffn_w_up, 1024, NUP, 88, (bf16_t*)(ws + WS_WT_UP0), scr, r, lane, norm_ffn_w, true, true); continue; } r -= I4;
                if (r < I4) { p0_transpose_item64(ffn_w_up + (size_t)1024 * NUP, 1024, NUP, 88, (bf16_t*)(ws + WS_WT_UP1), scr, r, lane, norm_ffn_w + 1024, true, true); continue; } r -= I4;
                if (r < I5) { p0_transpose_item64(ffn_w_down, DFF, 1024, 16, (bf16_t*)(ws + WS_WT_DN0), scr, r, lane, nullptr, false, true); continue; } r -= I5;
                p0_transpose_item64(ffn_w_down + (size_t)DFF * 1024, DFF, 1024, 16, (bf16_t*)(ws + WS_WT_DN1), scr, r, lane, nullptr, false, true);
            }
            for (int e = gtid; e < 32 * 1024; e += ngt) { const int k = e & 1023, ng = e >> 10; const float* wi = gla_w_in + (size_t)k * GLA_IN + 3072; const float nwk = norm_mixer_w[1024 + k];
                const f32x4 w0 = *(const f32x4*)(wi) * nwk, w1 = *(const f32x4*)(wi + 4) * nwk, w2 = *(const f32x4*)(wi + 8) * nwk, w3 = *(const f32x4*)(wi + 12) * nwk;
#pragma unroll 4
                for (int nn = 0; nn < 16; ++nn) { const int n = ng * 16 + nn; const float* gk = gla_w_gk + n;
                    float s = w0[0] * gk[0] + w0[1] * gk[512] + w0[2] * gk[1024] + w0[3] * gk[1536];
                    s += w1[0] * gk[2048] + w1[1] * gk[2560] + w1[2] * gk[3072] + w1[3] * gk[3584];
                    s += w2[0] * gk[4096] + w2[1] * gk[4608] + w2[2] * gk[5120] + w2[3] * gk[5632];
                    s += w3[0] * gk[6144] + w3[1] * gk[6656] + w3[2] * gk[7168] + w3[3] * gk[7680];
                    WT_GLA_IN[(size_t)(3072 + n) * 1024 + k] = (bf16_t)f2bf(s); } }

            if (gtid < 1024) { const float l0 = lb_logits[gtid], l1 = lb_logits[1024 + gtid], l2 = lb_logits[2048 + gtid]; const float mx = fmaxf(l0, fmaxf(l1, l2));
                const float e0 = __expf(l0 - mx), e1 = __expf(l1 - mx), e2 = __expf(l2 - mx); LB[gtid] = e0 / (e0 + e1 + e2); }
            rms_phase(x, norm_mixer_w, Y, gw, ngw, lane);
        }
        if (type == 2) { pg8::Gemm g{gA, gB, gM, gN, gK}; pg8::StaticOrder S; S.init(gM, gN, G, bx);
            pg8::EpiRes E{base, outp, 1024, baseb, hbp, ssqp, (hbp == ORAW) ? 1 : 0, nof32}; pg8::gemm_phase<pg8::EpiRes, pg8::StaticOrder, true, true>(lds, g, S, E); }
        if (type == 1) { pg8::Gemm g{gA, gB, gM, gN, gK}; pg8::StaticOrder S; S.init(gM, gN, G, bx);
            pg8::EpiProj E{kind, kind == 3 ? ACT : PQ_, PK_, PG_, PV_, PGATE, aux, NUP, cwp, cbp, HALO, rsp}; pg8::gemm_phase<pg8::EpiProj, pg8::StaticOrder, true, true>(lds, g, S, E); }
        if (type == 3) {
            float* SLOC = (float*)(ws + WS_ORAW); float* DSEG = SLOC + 12 * 1024 * 1024;
            if (L == 0) scan_phase<1024, 8, 1>(lds, PQ_, PK_, PG_, PV_, Y, SLOC, DSEG, PGATE, hg_norm_w, bx, G); else scan_phase<512, 4, 1>(lds, PQ_, PK_, PG_, PV_, Y, SLOC, DSEG, PGATE, gla_norm_w, bx, G);
            xcd_barrier(xbar);
            if (L == 0) scan_phase<1024, 8, 3>(lds, PQ_, PK_, PG_, PV_, Y, SLOC, DSEG, PGATE, hg_norm_w, bx, G); else scan_phase<512, 4, 3>(lds, PQ_, PK_, PG_, PV_, Y, SLOC, DSEG, PGATE, gla_norm_w, bx, G); }
        if (type == 6) glu_fixup_phase(HALO, ACT, cwp, cbp, gtid, ngt);
        if (type == 7) rms_final_bf16_phase(Y, SSQ + (size_t)3 * MROWS, norm_final_w, hres, gw, ngw, lane);
        ++ph;
        if (ph < ph_hi) { if (ph_lo < 0) grid.sync(); else xcd_barrier(xbar); }
    }

}

extern "C" void kernel_launch(void* const* d_in, const int* in_sizes, int n_in, void* d_out, int out_size, void* d_ws, size_t ws_size, hipStream_t stream) {
    static int grid = 0;
    if (grid == 0) {
        int dev = 0, cus = 0, per_cu = 0;
        hipGetDevice(&dev);
        hipDeviceGetAttribute(&cus, hipDeviceAttributeMultiprocessorCount, dev);
        hipFuncSetAttribute((const void*)fwd_kernel, hipFuncAttributeMaxDynamicSharedMemorySize, LDS_BYTES);
        hipOccupancyMaxActiveBlocksPerMultiprocessor(&per_cu, (const void*)fwd_kernel, 512, LDS_BYTES);
        if (per_cu < 1) per_cu = 1;
        grid = cus * per_cu;
        if (n_in != 17 || ws_size < WS_END) fprintf(stderr, "kernel_launch: unexpected n_in %d or ws_size %zu\n", n_in, ws_size);
    }
    hipMemsetAsync((char*)d_ws + WS_BAR, 0, XCD_BAR_WORDS * 4, stream);
    Args a{};
    for (int i = 0; i < 17; ++i) a.in[i] = (const float*)d_in[i];
    a.out = (float*)d_out; a.ws = (unsigned char*)d_ws;
    int lo = 0, hi = NPHASE;
    void* args[] = {&a, &lo, &hi};
    hipError_t e = hipLaunchCooperativeKernel((const void*)fwd_kernel, dim3(grid), dim3(512), args, LDS_BYTES, stream);
    if (e != hipSuccess) fprintf(stderr, "cooperative launch failed: %s (grid %d)\n", hipGetErrorString(e), grid);
}
```

```cpp
#include <hip/hip_runtime.h>
#include <hip/hip_cooperative_groups.h>
#include <cstdio>
namespace cg = cooperative_groups;
namespace pg8 {
#define PG8_LAS __attribute__((address_space(3)))
typedef unsigned short bf16_t;
typedef short bf16x8 __attribute__((ext_vector_type(8)));
typedef float f32x4 __attribute__((ext_vector_type(4)));
typedef unsigned u32x4 __attribute__((ext_vector_type(4)));
constexpr int BM = 256, BK = 64, HALF = 128, HTB = HALF * BK * 2  , STAGE_BYTES = 8 * HTB, NXCD = 8, WGM = 4;

__host__ __device__ __forceinline__ int lds_byte(int r, int c) { const int st = (r >> 4) * 2 + (c >> 5), rr = r & 15, cc = c & 31, ob = rr * 64 + cc * 2; return st * 1024 + (ob ^ (((ob >> 9) & 1) << 5)); }
__host__ __device__ __forceinline__ void stage_rc(int b, int& R, int& C) { const int st = b / 1024, sb = b % 1024, swz = sb ^ (((sb >> 9) & 1) << 5); R = (st >> 1) * 16 + swz / 64; C = (st & 1) * 32 + (swz % 64) / 2; }
__host__ __device__ __forceinline__ int perm32(int rho) { const int n = rho >> 4, i = rho & 15; return 8 * (i >> 2) + 4 * n + (i & 3); }

struct Unit { int pm, pn; };
struct Gemm { const bf16_t* A; const bf16_t* Bt; int M, N, K; };

struct StaticOrder {
    int nM, nN, nwg, G, c;
    __host__ __device__ void init(int M, int N, int G_, int c_) { nM = M / BM; nN = N / BM; nwg = nM * nN; G = G_; c = c_; }
    __host__ __device__ bool next(int i, Unit& u) const {
        const long L = (long)i * G + c; if (L >= nwg) return false;
        int wgid = (int)L; { const int q = nwg / NXCD, r = nwg % NXCD, xcd = wgid % NXCD, off = wgid / NXCD; wgid = (xcd < r ? xcd * (q + 1) : r * (q + 1) + (xcd - r) * q) + off; }
        const int nig = WGM * nN, gid = wgid / nig, fm = gid * WGM, gsz = (nM - fm) < WGM ? (nM - fm) : WGM;
        u.pm = fm + ((wgid % nig) % gsz); u.pn = (wgid % nig) / gsz; return true;
    }
    __device__ __forceinline__ void a_ready(const Unit&) const {}
    __device__ __forceinline__ void done(const Unit&) const {}
};
typedef float f32x2_ __attribute__((ext_vector_type(2)));
typedef __bf16 bf16v2_ __attribute__((ext_vector_type(2)));
__device__ __forceinline__ unsigned cvt_pk_bf16(float lo, float hi) { f32x2_ v = {lo, hi}; bf16v2_ r = __builtin_convertvector(v, bf16v2_); return __builtin_bit_cast(unsigned, r); }
__device__ __forceinline__ float fsilu(float x) { return x * __builtin_amdgcn_rcpf(1.0f + __expf(-x)); }
__device__ __forceinline__ float fsigm(float x) { return __builtin_amdgcn_rcpf(1.0f + __expf(-x)); }

__device__ __forceinline__ void dpp_shr12(float x, float& s1, float& s2) {
    asm volatile("s_nop 1\n\tv_mov_b32_dpp %0, %2 row_shr:1 row_mask:0xf bank_mask:0xf bound_ctrl:1\n\tv_mov_b32_dpp %1, %2 row_shr:2 row_mask:0xf bank_mask:0xf bound_ctrl:1" : "=&v"(s1), "=&v"(s2) : "v"(x)); }
__device__ __forceinline__ void dpp_ror12(float x, float& s1, float& s2) {
    asm volatile("s_nop 1\n\tv_mov_b32_dpp %0, %2 row_ror:1 row_mask:0xf bank_mask:0xf\n\tv_mov_b32_dpp %1, %2 row_ror:2 row_mask:0xf bank_mask:0xf" : "=&v"(s1), "=&v"(s2) : "v"(x)); }
__device__ __forceinline__ float row_ssq16(const unsigned long long* rs, int row) { return (float)rs[row] * (1.0f / 1048576.0f); }
struct EpiRes {
    static constexpr bool PERM = false, AFTER_DRAIN = false;
    const float* base; float* out; int ldc;
    const bf16_t* baseb;
    bf16_t* hb;
    unsigned long long* ssq;
    int ntout;
    int nof32;
    __device__ __forceinline__ void operator()(const f32x4 (&acc)[2][2][4][2], const Unit& u, int wr, int wc, int fr, int fq) const {
        const int row0 = u.pm * BM + wr * 64 + fr, col0 = u.pn * BM + wc * 32 + 4 * fq;
#pragma unroll
        for (int ai = 0; ai < 2; ++ai)
#pragma unroll
            for (int m = 0; m < 4; ++m) { const int row = row0 + ai * HALF + m * 16; const size_t ro = (size_t)row * ldc + col0; float part = 0.f;
#pragma unroll
                for (int bj = 0; bj < 2; ++bj)
#pragma unroll
                    for (int n = 0; n < 2; ++n) { f32x4 b; if (baseb) { const unsigned long long t = *(const unsigned long long*)(baseb + ro + bj * HALF + n * 16); const unsigned lo = (unsigned)t, hi = (unsigned)(t >> 32);
                            b = (f32x4){__builtin_bit_cast(float, lo << 16), __builtin_bit_cast(float, lo & 0xffff0000u), __builtin_bit_cast(float, hi << 16), __builtin_bit_cast(float, hi & 0xffff0000u)}; }
                        else b = *(const f32x4*)(base + ro + bj * HALF + n * 16); const f32x4 v = acc[ai][bj][m][n] + b; if (!nof32) { if (ntout) __builtin_nontemporal_store(v, (f32x4*)(out + ro + bj * HALF + n * 16)); else *(f32x4*)(out + ro + bj * HALF + n * 16) = v; }
                        part += (v[0] * v[0] + v[1] * v[1]) + (v[2] * v[2] + v[3] * v[3]);
                        if (hb) { unsigned lo = cvt_pk_bf16(v[0], v[1]), hi = cvt_pk_bf16(v[2], v[3]); *(unsigned long long*)(hb + ro + bj * HALF + n * 16) = (unsigned long long)lo | ((unsigned long long)hi << 32); } }
                if (ssq) { part += __shfl_xor(part, 16); part += __shfl_xor(part, 32); if (fq == 0) atomicAdd(ssq + row, (unsigned long long)(part * 1048576.0f + 0.5f)); } }
    }
};

struct EpiProj {
    static constexpr bool PERM = true, AFTER_DRAIN = false;
    int kind;
    bf16_t *o0, *o1, *o2, *o3, *o4;
    const float* aux;
    int ldplain;
    const float* cw; const float* cb;
    bf16_t* halo;
    const unsigned long long* rs;
    __device__ __forceinline__ void glu(const f32x4 (&acc)[2][2][4][2], const Unit& u, int wr, int wc, int fr, int fq) const {
        const int ch0 = u.pn * 128 + wc * 32 + 8 * fq;
#pragma unroll
        for (int ai = 0; ai < 2; ++ai) {
            const int rowg = u.pm * BM + ai * HALF + wr * 64;
            float rstd[4];
#pragma unroll
            for (int m = 0; m < 4; ++m) rstd[m] = 1.0f / sqrtf(row_ssq16(rs, rowg + 16 * m + fr) * (1.0f / 1024.0f) + 1e-6f);
#pragma unroll
            for (int hm = 0; hm < 2; ++hm) { const int m = hm ? 3 : 0; const bool doit = hm ? (fr >= 14) : (fr < 2); const int slot = hm ? (fr - 12) : fr;
                if (doit) { bf16_t* hp = halo + ((size_t)(rowg >> 6) * 4 + slot) * 5632 + ch0;
#pragma unroll
                    for (int bj = 0; bj < 2; ++bj) { const f32x4 v0 = acc[ai][bj][m][0] * rstd[m], v1 = acc[ai][bj][m][1] * rstd[m];
                        u32x4 w; w.x = cvt_pk_bf16(v0[0], v0[1]); w.y = cvt_pk_bf16(v0[2], v0[3]); w.z = cvt_pk_bf16(v1[0], v1[1]); w.w = cvt_pk_bf16(v1[2], v1[3]);
                        *(u32x4*)(hp + bj * 2816) = w; } } }
#pragma unroll
            for (int n = 0; n < 2; ++n) { const int ch = ch0 + 4 * n;
                const f32x4 wa0 = *(const f32x4*)(cw + ch), wa1 = *(const f32x4*)(cw + 5632 + ch), wa2 = *(const f32x4*)(cw + 2 * 5632 + ch), ba = *(const f32x4*)(cb + ch);
                const f32x4 wg0 = *(const f32x4*)(cw + 2816 + ch), wg1 = *(const f32x4*)(cw + 5632 + 2816 + ch), wg2 = *(const f32x4*)(cw + 2 * 5632 + 2816 + ch), bg = *(const f32x4*)(cb + 2816 + ch);
                f32x4 pa = (f32x4){0.f, 0.f, 0.f, 0.f}, pg = (f32x4){0.f, 0.f, 0.f, 0.f};
#pragma unroll
                for (int m = 0; m < 4; ++m) { const f32x4 xa = acc[ai][0][m][n] * rstd[m], xg = acc[ai][1][m][n] * rstd[m]; float r[4];
#pragma unroll
                    for (int j = 0; j < 4; ++j) {
                        float sa1, sa2, sg1, sg2; dpp_shr12(xa[j], sa1, sa2); dpp_shr12(xg[j], sg1, sg2);
                        float qa1, qa2, qg1, qg2; dpp_ror12(pa[j], qa1, qa2); dpp_ror12(pg[j], qg1, qg2);
                        const float pa1 = fr >= 1 ? sa1 : qa1, pa2 = fr >= 2 ? sa2 : qa2, pg1 = fr >= 1 ? sg1 : qg1, pg2 = fr >= 2 ? sg2 : qg2;
                        const float ua = ba[j] + wa0[j] * pa2 + wa1[j] * pa1 + wa2[j] * xa[j];
                        const float ug = bg[j] + wg0[j] * pg2 + wg1[j] * pg1 + wg2[j] * xg[j];
                        r[j] = fsilu(ug) * ua; }
                    pa = xa; pg = xg;
                    if (!(m == 0 && fr < 2)) { const unsigned lo = cvt_pk_bf16(r[0], r[1]), hi = cvt_pk_bf16(r[2], r[3]);
                        *(unsigned long long*)(o0 + (size_t)(rowg + 16 * m + fr) * 2816 + ch) = (unsigned long long)lo | ((unsigned long long)hi << 32); }
                    __builtin_amdgcn_sched_barrier(0); } }
        }
    }
    __device__ __forceinline__ void operator()(const f32x4 (&acc)[2][2][4][2], const Unit& u, int wr, int wc, int fr, int fq) const {
        if (kind == 3) { glu(acc, u, wr, wc, fr, fq); return; }
        int mode = 0, ld = ldplain, colt = u.pn * BM; bf16_t* ob = o0; bf16_t* ob2 = o0; float scale = 1.0f;
        bool nt = true;
        if (kind == 0) { const int sec = u.pn >> 2; colt = (u.pn & 3) * BM; ld = 1024;
            if (sec == 0) { mode = 1; ob = o0; scale = 0.08838834764831845f; } else if (sec == 1) { mode = 2; ob = o1; ob2 = o2; nt = false; } else if (sec == 2) { ob = o3; nt = false; } else { ob = o4; } }
        else if (kind == 1) { const int pn = u.pn;
            if (pn < 2) { ob = o0; ld = 512; colt = pn * BM; scale = 0.08838834764831845f; }
            else if (pn < 4) { ob = o1; ld = 512; colt = (pn - 2) * BM; nt = false; }
            else if (pn < 8) { ob = o3; ld = 1024; colt = (pn - 4) * BM; nt = false; }
            else if (pn < 12) { ob = o4; ld = 1024; colt = (pn - 8) * BM; }
            else { mode = 3; ob = o2; ld = 512; colt = (pn - 12) * BM; nt = false; } }
        const int row0 = u.pm * BM + wr * 64 + fr, col0 = colt + wc * 32 + 8 * fq;
        f32x4 av[2][2];
#pragma unroll
        for (int bj = 0; bj < 2; ++bj)
#pragma unroll
            for (int n = 0; n < 2; ++n) av[bj][n] = (mode >= 2) ? *(const f32x4*)(aux + col0 + bj * HALF + 4 * n) : (f32x4){0.f, 0.f, 0.f, 0.f};
#pragma unroll
        for (int ai = 0; ai < 2; ++ai)
#pragma unroll
            for (int m = 0; m < 4; ++m) { const size_t ro = (size_t)(row0 + ai * HALF + m * 16) * ld + col0;
                const float rstd = rs ? (1.0f / sqrtf(row_ssq16(rs, row0 + ai * HALF + m * 16) * (1.0f / 1024.0f) + 1e-6f)) : 1.0f;
                const float rsc = (mode == 1) ? rstd : rstd * scale;
#pragma unroll
                for (int bj = 0; bj < 2; ++bj) { f32x4 v0 = acc[ai][bj][m][0] * rsc, v1 = acc[ai][bj][m][1] * rsc;
                    if (mode == 0) { }
                    else if (mode == 1) {
#pragma unroll
                        for (int j = 0; j < 4; ++j) { v0[j] = fsilu(v0[j]) * scale; v1[j] = fsilu(v1[j]) * scale; } }
                    else if (mode == 2) {
#pragma unroll
                        for (int j = 0; j < 4; ++j) { const float lb0 = av[bj][0][j], lb1 = av[bj][1][j]; v0[j] = (1.0f - lb0) * fsigm(-v0[j]); v1[j] = (1.0f - lb1) * fsigm(-v1[j]); } }
                    else {
#pragma unroll
                        for (int j = 0; j < 4; ++j) { const float x0 = v0[j] + av[bj][0][j], x1 = v1[j] + av[bj][1][j];
                            v0[j] = (fminf(x0, 0.f) - __logf(1.0f + __expf(-fabsf(x0)))) * (0.0625f * 1.4426950408889634f); v1[j] = (fminf(x1, 0.f) - __logf(1.0f + __expf(-fabsf(x1)))) * (0.0625f * 1.4426950408889634f);   } }
                    u32x4 w; w.x = cvt_pk_bf16(v0[0], v0[1]); w.y = cvt_pk_bf16(v0[2], v0[3]); w.z = cvt_pk_bf16(v1[0], v1[1]); w.w = cvt_pk_bf16(v1[2], v1[3]);
                    if (nt) __builtin_nontemporal_store(w, (u32x4*)(ob + ro + bj * HALF)); else *(u32x4*)(ob + ro + bj * HALF) = w; } }
    }
};
template <class Epi, class Sched, bool ALIGN_EPI = false, bool SP2 = false>
__device__ __forceinline__ void gemm_phase(PG8_LAS unsigned char* lds, const Gemm g, const Sched& S, const Epi& E) {
    int tid_ = threadIdx.x; asm volatile("" : "+v"(tid_)); const int tid = tid_, wid = __builtin_amdgcn_readfirstlane(tid >> 6), lane = tid & 63, wr = wid >> 2, wc = wid & 3, fr = lane & 15, fq = lane >> 4;
    const int K = g.K, nt = K / BK;
    unsigned voffA[2], voffB[2];
#pragma unroll
    for (int i = 0; i < 2; ++i) { int R, C; stage_rc(tid * 16 + i * 8192, R, C); const int Rb = Epi::PERM ? ((R & ~31) + perm32(R & 31)) : R;
        voffA[i] = (unsigned)(R * K + C) * 2u; voffB[i] = (unsigned)(Rb * K + C) * 2u; }
    const size_t kstep = (size_t)(BK * 2);
    const size_t hstep = (size_t)HALF * K * 2;
    const size_t tstep = 2 * hstep;
    const unsigned ldsw = (unsigned)wid * 1024u;
    const int aoff = lds_byte(wr * 64 + fr, fq * 8), boff = lds_byte(wc * 32 + fr, fq * 8);
#define PG8_SA(b, h) (((b) * 2 + (h)) * HTB)
#define PG8_SB(b, h) ((4 + (b) * 2 + (h)) * HTB)
#define PG8_STAGE(bufoff, gbase, voff) do { _Pragma("unroll") for (int _i = 0; _i < 2; ++_i) \
        __builtin_amdgcn_global_load_lds((const unsigned*)((const char*)(gbase) + (voff)[_i]), (PG8_LAS unsigned*)(lds + (bufoff) + ldsw + _i * 8192), 16, 0, 0); } while (0)
#define PG8_LDA(dst, b, h) do { _Pragma("unroll") for (int m = 0; m < 4; ++m) _Pragma("unroll") for (int k = 0; k < 2; ++k) dst[m][k] = *(const PG8_LAS bf16x8*)(lds + PG8_SA(b, h) + aoff + m * 2048 + k * 1024); } while (0)
#define PG8_LDB(dst, b, h) do { _Pragma("unroll") for (int n = 0; n < 2; ++n) _Pragma("unroll") for (int k = 0; k < 2; ++k) dst[n][k] = *(const PG8_LAS bf16x8*)(lds + PG8_SB(b, h) + boff + n * 2048 + k * 1024); } while (0)
#define PG8_MMA(ai, bj, At, Bt) do { __builtin_amdgcn_s_setprio(1); _Pragma("unroll") for (int m = 0; m < 4; ++m) _Pragma("unroll") for (int n = 0; n < 2; ++n) _Pragma("unroll") for (int k = 0; k < 2; ++k) \
        acc[ai][bj][m][n] = __builtin_amdgcn_mfma_f32_16x16x32_bf16(Bt[n][k], At[m][k], acc[ai][bj][m][n], 0, 0, 0); __builtin_amdgcn_s_setprio(0); } while (0)
#define PG8_WAIT_V(n) asm volatile("s_waitcnt vmcnt(" #n ")" ::: "memory")
#define PG8_WAIT_L(n) asm volatile("s_waitcnt lgkmcnt(" #n ")" ::: "memory")
#define PG8_BAR __builtin_amdgcn_s_barrier()
#define PG8_SCHED __builtin_amdgcn_sched_barrier(0)
    Unit cur, nxt; int ui = 0;
    if (!S.next(0, cur)) return;
    f32x4 acc[2][2][4][2];
#pragma unroll
    for (int a = 0; a < 2; ++a)
#pragma unroll
        for (int b = 0; b < 2; ++b)
#pragma unroll
            for (int m = 0; m < 4; ++m)
#pragma unroll
                for (int n = 0; n < 2; ++n) acc[a][b][m][n] = (f32x4){0.f, 0.f, 0.f, 0.f};
    bf16x8 At[4][2], B0[2][2], B1[2][2];
    const char* cA = (const char*)g.A + (size_t)cur.pm * tstep; const char* cB = (const char*)g.Bt + (size_t)cur.pn * tstep;
    S.a_ready(cur);
    if constexpr (SP2) {
        PG8_STAGE(PG8_SB(0, 0), cB, voffB); PG8_STAGE(PG8_SB(0, 1), cB + hstep, voffB); PG8_STAGE(PG8_SA(0, 0), cA, voffA); PG8_STAGE(PG8_SA(0, 1), cA + hstep, voffA);
        if (wr == 1) PG8_BAR;
        PG8_WAIT_V(2); PG8_BAR;
        PG8_STAGE(PG8_SB(1, 0), cB + kstep, voffB); PG8_STAGE(PG8_SA(1, 0), cA + kstep, voffA); PG8_STAGE(PG8_SB(1, 1), cB + hstep + kstep, voffB);
        PG8_WAIT_V(6); PG8_BAR;
    } else {
        PG8_STAGE(PG8_SB(0, 0), cB, voffB); PG8_STAGE(PG8_SA(0, 0), cA, voffA); PG8_STAGE(PG8_SB(0, 1), cB + hstep, voffB); PG8_STAGE(PG8_SA(0, 1), cA + hstep, voffA);
        if (wr == 1) PG8_BAR;
        PG8_WAIT_V(4); PG8_BAR;
        PG8_STAGE(PG8_SB(1, 0), cB + kstep, voffB); PG8_STAGE(PG8_SA(1, 0), cA + kstep, voffA); PG8_STAGE(PG8_SB(1, 1), cB + hstep + kstep, voffB);
        PG8_WAIT_V(6); PG8_BAR;
    }
    for (;;) {
        const bool has_next = S.next(ui + 1, nxt);
        const char* nA = has_next ? (const char*)g.A + (size_t)nxt.pm * tstep : cA; const char* nB = has_next ? (const char*)g.Bt + (size_t)nxt.pn * tstep : cB;
        for (int t = 0; t < nt; t += 2) {
            const bool last = (t == nt - 2);
            const char* a1 = cA + (size_t)(t + 1) * kstep;
            const char* a2 = last ? nA : cA + (size_t)(t + 2) * kstep; const char* b2 = last ? nB : cB + (size_t)(t + 2) * kstep;
            const char* a3 = a2 + kstep; const char* b3 = b2 + kstep;
            if (last && has_next) S.a_ready(nxt);
            if constexpr (SP2) {
            PG8_LDB(B0, 0, 0); PG8_LDB(B1, 0, 1); PG8_SCHED; PG8_LDA(At, 0, 0); PG8_STAGE(PG8_SA(1, 1), a1 + hstep, voffA);
            PG8_WAIT_V(8); PG8_WAIT_L(0); PG8_BAR; PG8_MMA(0, 0, At, B0); PG8_MMA(0, 1, At, B1); PG8_BAR; PG8_SCHED;
            PG8_LDA(At, 0, 1); PG8_STAGE(PG8_SB(0, 0), b2, voffB); PG8_STAGE(PG8_SB(0, 1), b2 + hstep, voffB); PG8_STAGE(PG8_SA(0, 0), a2, voffA);
            PG8_WAIT_V(8); PG8_WAIT_L(0); PG8_BAR; PG8_MMA(1, 0, At, B0); PG8_MMA(1, 1, At, B1); PG8_BAR; PG8_SCHED;
            PG8_LDB(B0, 1, 0); PG8_LDB(B1, 1, 1); PG8_SCHED; PG8_LDA(At, 1, 0); PG8_STAGE(PG8_SA(0, 1), a2 + hstep, voffA);
            PG8_WAIT_V(8); PG8_WAIT_L(0); PG8_BAR; PG8_MMA(0, 0, At, B0); PG8_MMA(0, 1, At, B1); PG8_BAR; PG8_SCHED;
            PG8_LDA(At, 1, 1); PG8_STAGE(PG8_SB(1, 0), b3, voffB); PG8_STAGE(PG8_SB(1, 1), b3 + hstep, voffB); PG8_STAGE(PG8_SA(1, 0), a3, voffA);
            PG8_WAIT_V(8); PG8_WAIT_L(0); PG8_BAR; PG8_MMA(1, 0, At, B0); PG8_MMA(1, 1, At, B1); PG8_BAR; PG8_SCHED;
            } else {
            PG8_LDB(B0, 0, 0); PG8_SCHED; PG8_LDA(At, 0, 0); PG8_STAGE(PG8_SA(1, 1), a1 + hstep, voffA);
            PG8_WAIT_L(8); PG8_BAR; PG8_WAIT_L(0); PG8_MMA(0, 0, At, B0); PG8_BAR; PG8_SCHED;
            PG8_LDB(B1, 0, 1); PG8_STAGE(PG8_SB(0, 0), b2, voffB);
            PG8_BAR; PG8_WAIT_L(0); PG8_MMA(0, 1, At, B1); PG8_BAR;
            PG8_LDA(At, 0, 1); PG8_STAGE(PG8_SA(0, 0), a2, voffA);
            PG8_BAR; PG8_WAIT_L(0); PG8_MMA(1, 0, At, B0); PG8_BAR; PG8_SCHED;
            PG8_STAGE(PG8_SB(0, 1), b2 + hstep, voffB);
            PG8_WAIT_V(6); PG8_BAR; PG8_MMA(1, 1, At, B1); PG8_BAR;
            PG8_LDB(B0, 1, 0); PG8_SCHED; PG8_LDA(At, 1, 0); PG8_STAGE(PG8_SA(0, 1), a2 + hstep, voffA);
            PG8_WAIT_L(8); PG8_BAR; PG8_WAIT_L(0); PG8_MMA(0, 0, At, B0); PG8_BAR; PG8_SCHED;
            PG8_LDB(B1, 1, 1); PG8_STAGE(PG8_SB(1, 0), b3, voffB);
            PG8_BAR; PG8_WAIT_L(0); PG8_MMA(0, 1, At, B1); PG8_BAR;
            PG8_LDA(At, 1, 1); PG8_STAGE(PG8_SA(1, 0), a3, voffA);
            PG8_BAR; PG8_WAIT_L(0); PG8_MMA(1, 0, At, B0); PG8_BAR; PG8_SCHED;
            PG8_STAGE(PG8_SB(1, 1), b3 + hstep, voffB);
            PG8_WAIT_V(6); PG8_BAR; PG8_MMA(1, 1, At, B1); PG8_BAR;
            }
        }
        if constexpr (ALIGN_EPI) { if (wr == 0) PG8_BAR; }
        if constexpr (!Epi::AFTER_DRAIN) { E(acc, cur, wr, wc, fr, fq); S.done(cur); }
        if (!has_next) break;
#pragma unroll
        for (int a = 0; a < 2; ++a)
#pragma unroll
            for (int b = 0; b < 2; ++b)
#pragma unroll
                for (int m = 0; m < 4; ++m)
#pragma unroll
                    for (int n = 0; n < 2; ++n) acc[a][b][m][n] = (f32x4){0.f, 0.f, 0.f, 0.f};
        cur = nxt; cA = nA; cB = nB; ++ui;
        if constexpr (ALIGN_EPI) { if (wr == 1) PG8_BAR; }
    }
    PG8_WAIT_V(0);
    if constexpr (!ALIGN_EPI) { if (wr == 0) PG8_BAR; }
    PG8_BAR;
    if constexpr (Epi::AFTER_DRAIN) { E.fused(acc, cur, wr, wc, fr, fq, lds, wid, lane); S.done(cur); }
#undef PG8_SA
#undef PG8_SB
#undef PG8_STAGE
#undef PG8_LDA
#undef PG8_LDB
#undef PG8_MMA
#undef PG8_WAIT_V
#undef PG8_WAIT_L
#undef PG8_BAR
#undef PG8_SCHED
}
}
using pg8::bf16_t; using pg8::bf16x8; using pg8::f32x4; using pg8::u32x4;
#define LAS __attribute__((address_space(3)))
typedef unsigned u32x2 __attribute__((ext_vector_type(2)));
typedef float f32x2 __attribute__((ext_vector_type(2)));

constexpr int MROWS = 32768, DM = 1024, TSEQ = 4096, DFF = 2816, NUP = 5632, GLA_IN = 3088, NGLA = 3584;
constexpr int MH = MROWS / 2;
constexpr float EPS = 1e-6f;
constexpr size_t MiB = 1u << 20;
constexpr size_t WS_BAR = 65536;
constexpr size_t WS_LB = 0;
constexpr size_t WS_SSQ = 1 * MiB;
constexpr size_t WS_WT_HG_IN = 2 * MiB, WS_WT_HG_OUT = 10 * MiB, WS_WT_GLA_IN = 12 * MiB, WS_WT_GLA_OUT = 19 * MiB;
constexpr size_t WS_WT_UP0 = 21 * MiB, WS_WT_UP1 = 32 * MiB, WS_WT_DN0 = 43 * MiB, WS_WT_DN1 = 49 * MiB;
constexpr size_t WS_Y = 56 * MiB;
constexpr size_t WS_P = 120 * MiB;
constexpr size_t WS_ORAW = 440 * MiB;
constexpr size_t WS_ACT = 120 * MiB;
constexpr size_t WS_HALO = 300 * MiB;
constexpr size_t WS_END = 504 * MiB;
constexpr int XB_LDS_OFF = 150528;
constexpr int LDS_BYTES = 151552;

__device__ __forceinline__ unsigned f2bf(float f) { unsigned u = __builtin_bit_cast(unsigned, f); return (u + 0x7fffu + ((u >> 16) & 1u)) >> 16; }
__device__ __forceinline__ unsigned pk2(float lo, float hi) { return pg8::cvt_pk_bf16(lo, hi); }
__device__ __forceinline__ float bflo(unsigned w) { return __builtin_bit_cast(float, w << 16); }
__device__ __forceinline__ float bfhi(unsigned w) { return __builtin_bit_cast(float, w & 0xffff0000u); }
__device__ __forceinline__ float wave_sum(float v) {
#pragma unroll
    for (int o = 1; o < 64; o <<= 1) v += __shfl_xor(v, o);
    return v;
}

struct Args { const float* in[17]; float* out; unsigned char* ws; };

__device__ __forceinline__ void p0_transpose_item64(const float* W, int K, int ldw, int nblk2, bf16_t* WT, LAS float* scr, int item, int lane, const float* rsc = nullptr, bool glu_perm = false, bool ntst = false) {
    const int kb = item / nblk2, nb = item % nblk2, k0 = 64 * kb, n0 = 64 * nb;
    float v0[32], v1[32];
#pragma unroll
    for (int i = 0; i < 32; ++i) { const size_t ro = (size_t)(k0 + 2 * i + (lane >> 5)) * ldw + n0 + (lane & 31); v0[i] = __builtin_nontemporal_load(W + ro); v1[i] = __builtin_nontemporal_load(W + ro + 32); }
    if (rsc) {
#pragma unroll
        for (int i = 0; i < 32; ++i) { const float r = rsc[k0 + 2 * i + (lane >> 5)]; v0[i] *= r; v1[i] *= r; } }
#pragma unroll
    for (int h = 0; h < 2; ++h) {
#pragma unroll
        for (int i = 0; i < 32; ++i) scr[(2 * i + (lane >> 5)) * 33 + (lane & 31)] = h ? v1[i] : v0[i];
        asm volatile("s_waitcnt lgkmcnt(0)" ::: "memory");
        const int c = lane & 7;
#pragma unroll
        for (int j = 0; j < 4; ++j) { const int n = (lane >> 3) + 8 * j; const LAS float* s = scr + (8 * c) * 33 + n;
            u32x4 o; o.x = pk2(s[0 * 33], s[1 * 33]); o.y = pk2(s[2 * 33], s[3 * 33]); o.z = pk2(s[4 * 33], s[5 * 33]); o.w = pk2(s[6 * 33], s[7 * 33]);
            int drow = n0 + 32 * h + n; if (glu_perm) { const int half = drow >= DFF ? 1 : 0, cc = drow - half * DFF; drow = 256 * (cc >> 7) + 128 * half + (cc & 127); }
            if (ntst) __builtin_nontemporal_store(o, (u32x4*)(WT + (size_t)drow * K + k0 + 8 * c)); else *(u32x4*)(WT + (size_t)drow * K + k0 + 8 * c) = o; }
        asm volatile("s_waitcnt lgkmcnt(0)" ::: "memory");
    }
}

__device__ __forceinline__ void rms_phase(const float* x, const float* w, bf16_t* y, int gw, int ngw, int lane) {
    constexpr int R = 4;
    const f32x4* wr = (const f32x4*)w + lane;
    for (int m = gw; m < MROWS; m += R * ngw) {
        f32x4 v[R][4]; float s[R];
#pragma unroll
        for (int r = 0; r < R; ++r) { const int mr = (m + r * ngw < MROWS) ? m + r * ngw : m; const f32x4* xa = (const f32x4*)(x + (size_t)mr * DM) + lane;
#pragma unroll
            for (int j = 0; j < 4; ++j) v[r][j] = __builtin_nontemporal_load(xa + 64 * j); }
#pragma unroll
        for (int r = 0; r < R; ++r) { float a = 0.f;
#pragma unroll
            for (int j = 0; j < 4; ++j) a += (v[r][j].x * v[r][j].x + v[r][j].y * v[r][j].y) + (v[r][j].z * v[r][j].z + v[r][j].w * v[r][j].w);
            s[r] = 1.0f / sqrtf(wave_sum(a) * (1.f / DM) + EPS); }
#pragma unroll
        for (int r = 0; r < R; ++r) { const int mr = (m + r * ngw < MROWS) ? m + r * ngw : m; u32x2* oa = (u32x2*)(y + (size_t)mr * DM) + lane;
#pragma unroll
            for (int j = 0; j < 4; ++j) { const f32x4 ww = wr[64 * j]; u32x2 o;
                o.x = pk2(v[r][j].x * s[r] * ww.x, v[r][j].y * s[r] * ww.y); o.y = pk2(v[r][j].z * s[r] * ww.z, v[r][j].w * s[r] * ww.w); oa[64 * j] = o; } }
    }
}

__device__ __forceinline__ void rms_final_bf16_phase(const bf16_t* hb, const unsigned long long* ssq, const float* w, float* out, int gw, int ngw, int lane) {
    constexpr int R = 4;
    const f32x4* wr = (const f32x4*)w + 2 * lane;
    for (int m = gw; m < MROWS; m += R * ngw) {
        u32x4 v[R][2]; float rs[R];
#pragma unroll
        for (int r = 0; r < R; ++r) { const int mr = (m + r * ngw < MROWS) ? m + r * ngw : m;
#pragma unroll
            for (int j = 0; j < 2; ++j) v[r][j] = __builtin_nontemporal_load((const u32x4*)(hb + (size_t)mr * DM + 512 * j + 8 * lane));
            rs[r] = 1.0f / sqrtf(pg8::row_ssq16(ssq, mr) * (1.f / DM) + EPS); }
#pragma unroll
        for (int r = 0; r < R; ++r) { if (r && m + r * ngw >= MROWS) continue; const int mr = m + r * ngw;
#pragma unroll
            for (int j = 0; j < 2; ++j) { const f32x4 w0 = wr[128 * j], w1 = wr[128 * j + 1]; f32x4* oa = (f32x4*)(out + (size_t)mr * DM + 512 * j + 8 * lane);
                __builtin_nontemporal_store((f32x4){bflo(v[r][j].x), bfhi(v[r][j].x), bflo(v[r][j].y), bfhi(v[r][j].y)} * rs[r] * w0, oa); __builtin_nontemporal_store((f32x4){bflo(v[r][j].z), bfhi(v[r][j].z), bflo(v[r][j].w), bfhi(v[r][j].w)} * rs[r] * w1, oa + 1); } }
    }
}

__device__ __forceinline__ void glu_fixup_phase(const bf16_t* HALO, bf16_t* ACT, const float* cw, const float* cb, int gtid, int ngt) {
    constexpr int CG = DFF / 8, NG = MROWS / 64, NITEM = NG * CG;
    for (int it = gtid; it < NITEM; it += ngt) {
        const int cgp = it % CG, gg = it / CG, c0 = cgp * 8;
        const bool seq_start = ((gg * 64) % TSEQ) == 0;
        float um2[2][8], um1[2][8], u0[2][8], u1[2][8];
#pragma unroll
        for (int hf = 0; hf < 2; ++hf) {
            const bf16_t* hc = HALO + (size_t)gg * 4 * NUP + hf * DFF + c0;
            const u32x4 r0 = *(const u32x4*)(hc), r1 = *(const u32x4*)(hc + NUP);
            u32x4 p2 = (u32x4){0u, 0u, 0u, 0u}, p1 = (u32x4){0u, 0u, 0u, 0u};
            if (!seq_start) { const bf16_t* hp = HALO + (size_t)(gg - 1) * 4 * NUP + hf * DFF + c0; p2 = *(const u32x4*)(hp + 2 * NUP); p1 = *(const u32x4*)(hp + 3 * NUP); }
            um2[hf][0] = bflo(p2.x); um2[hf][1] = bfhi(p2.x); um2[hf][2] = bflo(p2.y); um2[hf][3] = bfhi(p2.y); um2[hf][4] = bflo(p2.z); um2[hf][5] = bfhi(p2.z); um2[hf][6] = bflo(p2.w); um2[hf][7] = bfhi(p2.w);
            um1[hf][0] = bflo(p1.x); um1[hf][1] = bfhi(p1.x); um1[hf][2] = bflo(p1.y); um1[hf][3] = bfhi(p1.y); um1[hf][4] = bflo(p1.z); um1[hf][5] = bfhi(p1.z); um1[hf][6] = bflo(p1.w); um1[hf][7] = bfhi(p1.w);
            u0[hf][0] = bflo(r0.x); u0[hf][1] = bfhi(r0.x); u0[hf][2] = bflo(r0.y); u0[hf][3] = bfhi(r0.y); u0[hf][4] = bflo(r0.z); u0[hf][5] = bfhi(r0.z); u0[hf][6] = bflo(r0.w); u0[hf][7] = bfhi(r0.w);
            u1[hf][0] = bflo(r1.x); u1[hf][1] = bfhi(r1.x); u1[hf][2] = bflo(r1.y); u1[hf][3] = bfhi(r1.y); u1[hf][4] = bflo(r1.z); u1[hf][5] = bfhi(r1.z); u1[hf][6] = bflo(r1.w); u1[hf][7] = bfhi(r1.w);
        }
        float o0[8], o1[8];
#pragma unroll
        for (int e = 0; e < 8; ++e) { const int ch = c0 + e;
            const float wa0 = cw[ch], wa1 = cw[NUP + ch], wa2 = cw[2 * NUP + ch], ba = cb[ch];
            const float wg0 = cw[DFF + ch], wg1 = cw[NUP + DFF + ch], wg2 = cw[2 * NUP + DFF + ch], bg = cb[DFF + ch];
            const float a0 = ba + wa0 * um2[0][e] + wa1 * um1[0][e] + wa2 * u0[0][e], g0 = bg + wg0 * um2[1][e] + wg1 * um1[1][e] + wg2 * u0[1][e];
            const float a1 = ba + wa0 * um1[0][e] + wa1 * u0[0][e] + wa2 * u1[0][e], g1 = bg + wg0 * um1[1][e] + wg1 * u0[1][e] + wg2 * u1[1][e];
            o0[e] = pg8::fsilu(g0) * a0; o1[e] = pg8::fsilu(g1) * a1; }
        u32x4 w0, w1; w0.x = pk2(o0[0], o0[1]); w0.y = pk2(o0[2], o0[3]); w0.z = pk2(o0[4], o0[5]); w0.w = pk2(o0[6], o0[7]);
        w1.x = pk2(o1[0], o1[1]); w1.y = pk2(o1[2], o1[3]); w1.z = pk2(o1[4], o1[5]); w1.w = pk2(o1[6], o1[7]);
        *(u32x4*)(ACT + (size_t)(gg * 64) * DFF + c0) = w0; *(u32x4*)(ACT + (size_t)(gg * 64 + 1) * DFF + c0) = w1;
    }
}

#define XB_TMO      128
#define XB_XCNT(j)  (256  + 64 * (j))
#define XB_XSUB(j)  (1280 + 64 * (j))
#define XB_XGEN(j)  (2304 + 64 * (j))
#define XB_TOP      3328
#define XB_TOPGEN   3392
#define XCD_BAR_WORDS 3456
#define XB_SPIN_CAP (1u << 18)

__device__ __forceinline__ unsigned xb_ld(unsigned* p)              { return __hip_atomic_load(p, __ATOMIC_RELAXED, __HIP_MEMORY_SCOPE_AGENT); }
__device__ __forceinline__ unsigned xb_add(unsigned* p, unsigned v) { return __hip_atomic_fetch_add(p, v, __ATOMIC_RELAXED, __HIP_MEMORY_SCOPE_AGENT); }
__device__ __forceinline__ unsigned xb_xcc_id() { return (unsigned)__builtin_amdgcn_s_getreg((3 << 11) | 20) & 0xFu; }
#define XB_SPIN(cond, bar) do { unsigned _sp = 0; while (cond) { __builtin_amdgcn_s_sleep(1); \
    if ((++_sp & 255u) == 0u) { if (xb_ld(&(bar)[XB_TMO])) break; if (_sp > XB_SPIN_CAP) { atomicAdd(&(bar)[XB_TMO], 1u); break; } } } } while (0)

struct XcdBarrier {
    unsigned* bar; unsigned x;
    volatile LAS unsigned* st;
};

__device__ __forceinline__ XcdBarrier xcd_barrier_post(unsigned* bar, volatile LAS unsigned* st) {
    XcdBarrier b; b.bar = bar; b.x = xb_xcc_id(); b.st = st;
    if (threadIdx.x == 0) st[2] = xb_add(&bar[XB_XCNT(b.x)], 1u);
    return b;
}
__device__ __forceinline__ void xcd_barrier_complete(unsigned* bar, unsigned x, unsigned& nloc, unsigned& nx) {
    const unsigned G = gridDim.x * gridDim.y * gridDim.z;
    unsigned sum, cnt, mine, sp = 0u;
    for (;;) {
        sum = 0u; cnt = 0u; mine = 0u;
#pragma unroll
        for (unsigned j = 0; j < 16; ++j) { const unsigned c = xb_ld(&bar[XB_XCNT(j)]); sum += c; cnt += (c > 0u) ? 1u : 0u; mine = (j == x) ? c : mine; }
        if (sum == G) break;
        __builtin_amdgcn_s_sleep(1);
        if ((++sp & 255u) == 0u) { if (xb_ld(&bar[XB_TMO])) break; if (sp > XB_SPIN_CAP) { atomicAdd(&bar[XB_TMO], 1u); break; } }
    }
    nloc = mine > 0u ? mine : 1u; nx = cnt > 0u ? cnt : 1u;
}

__device__ __forceinline__ void xcd_barrier(const XcdBarrier& b) {
    asm volatile("s_waitcnt vmcnt(0)" ::: "memory");
    __syncthreads();
    if (threadIdx.x == 0) {
        unsigned* bar = b.bar;
        __builtin_amdgcn_s_waitcnt(0);
        unsigned nloc = b.st[0], nx = b.st[1];
        if (nloc == 0u) { xcd_barrier_complete(bar, b.x, nloc, nx); b.st[0] = nloc; b.st[1] = nx; }
        const unsigned old = xb_add(&bar[XB_XSUB(b.x)], 1u);
        const unsigned gen = old / nloc;
        if (old + 1u == (gen + 1u) * nloc) {
            __builtin_amdgcn_fence(__ATOMIC_RELEASE, "agent");
            asm volatile("s_waitcnt vmcnt(0)" ::: "memory");
            const unsigned og = xb_add(&bar[XB_TOP], 1u);
            const unsigned tg = og / nx;
            if (og + 1u == (tg + 1u) * nx) xb_add(&bar[XB_TOPGEN], 1u);
            else XB_SPIN(xb_ld(&bar[XB_TOPGEN]) == tg, bar);
            __builtin_amdgcn_fence(__ATOMIC_ACQUIRE, "agent");
            xb_add(&bar[XB_XGEN(b.x)], 1u);
            asm volatile("s_waitcnt vmcnt(0)" ::: "memory");
        } else {
            XB_SPIN(xb_ld(&bar[XB_XGEN(b.x)]) == gen, bar);
            __builtin_amdgcn_fence(__ATOMIC_ACQUIRE, "agent");
            asm volatile("s_waitcnt vmcnt(0)" ::: "memory");
        }
    }
    __syncthreads();
}
__device__ __forceinline__ int offb(int row, int ch) { return 256 * row + 16 * (ch ^ (((row & 3) << 2) | ((row >> 2) & 3))); }
typedef short s16x4 __attribute__((ext_vector_type(4)));
__device__ __forceinline__ int tr_lane_const(int fr, int fq) { const int q = fr >> 2, p = fr & 3; return 256 * (8 * fq + q) + 8 * (p & 1) + 16 * ((((q << 2) | ((2 * fq) & 3))) ^ (p >> 1)); }
__device__ __forceinline__ bf16x8 tr_frag(LAS unsigned char* lds, int imgoff, int c, int ks, int LX) {
    const s16x4 a = __builtin_amdgcn_ds_read_tr16_b64_v4i16((LAS s16x4*)(lds + (imgoff + 8192 * ks) + (LX ^ (32 * c))));
    const s16x4 b = __builtin_amdgcn_ds_read_tr16_b64_v4i16((LAS s16x4*)(lds + (imgoff + 8192 * ks + 1024) + ((LX ^ 16) ^ (32 * c))));
    return __builtin_shufflevector(a, b, 0, 1, 2, 3, 4, 5, 6, 7);
}
constexpr int PQ = 272, PS = 144;
#define SCAN_BAR() do { asm volatile("s_waitcnt lgkmcnt(0)" ::: "memory"); __builtin_amdgcn_s_barrier(); asm volatile("" ::: "memory"); } while (0)
#define MFMA16(a, b, c) __builtin_amdgcn_mfma_f32_16x16x32_bf16((a), (b), (c), 0, 0, 0)
constexpr int SCAN_LDS_MAX = 150528;

template <int LDQK, int HEADS, int PASS>
__device__ __forceinline__ void scan_phase(LAS unsigned char* lds, const bf16_t* Q, const bf16_t* K, const bf16_t* G, const bf16_t* V, bf16_t* O, float* SLOC, float* DSEG, const bf16_t* GATE, const float* nw, int bx, int nblk) {
    int tid_ = threadIdx.x; asm volatile("" : "+v"(tid_)); const int tid = tid_, lane = tid & 63, w = __builtin_amdgcn_readfirstlane(tid >> 6);
    const int fr = lane & 15, fq = lane >> 4, tb = w >> 1, vh = w & 1, LX = tr_lane_const(fr, fq);
    constexpr int DVH = 1024 / HEADS, NX = DVH / 16, NXH = NX / 2, NSEG = 256 / (8 * HEADS), CPS = 64 / NSEG, NVP = NX / 4, CPR = 2 * NX  , RPP = 512 / CPR  ;
    constexpr int SC_QB = 0, SC_KT = 17408, SC_V = 33792, SC_P = SC_V + 4096 * NVP * 2, SC_ST = SC_P + 9216, SC_SEG = SC_ST + 16 * NX * PQ, SC_EBL = SC_SEG + 4096, SC_NRM = SC_EBL + 512;
    static_assert(SC_NRM + 512 <= SCAN_LDS_MAX, "scan LDS map");
    constexpr bool GFROMK = (HEADS == 8);
    for (int u = bx; u < 256; u += nblk) {
        const int seg = u % NSEG, seq = u / NSEG;
        if (PASS == 1 && seg == NSEG - 1) continue;
        const int b = seq / HEADS, h = seq % HEADS;
        const size_t row0 = (size_t)b * TSEQ + (size_t)seg * CPS * 64;
        const int voff = h * DVH;
        const bf16_t* qp = Q + row0 * LDQK + h * 128; const bf16_t* kp = K + row0 * LDQK + h * 128; const bf16_t* gp = G + row0 * LDQK + h * 128;
        const bf16_t* vp = V + row0 * 1024 + voff; bf16_t* op = O + row0 * 1024 + voff; const bf16_t* gtp = GATE + row0 * 1024 + voff;
        const unsigned lqk = 2u * (unsigned)lane, lv = (unsigned)(tid / CPR) * 1024u + 8u * (unsigned)(tid % CPR), lo = (unsigned)(16 * tb + fr) * 1024u + (unsigned)(16 * NXH * vh + 4 * fq);
        f32x4 S[NX];
#pragma unroll
        for (int x = 0; x < NX; ++x) S[x] = (f32x4){0.f, 0.f, 0.f, 0.f};
        f32x4 dacc = (f32x4){1.f, 1.f, 1.f, 1.f};
        if (PASS == 3) {
            for (int sp = 0; sp < seg; ++sp) { const int up = u - seg + sp;
                const f32x4 d = *(const f32x4*)(DSEG + (size_t)up * 128 + 16 * w + 4 * fq);
#pragma unroll
                for (int x = 0; x < NX; ++x) { const u32x2 sb = *((const u32x2*)SLOC + (((size_t)up * 8 + w) * NX + x) * 64 + lane);
                    const f32x4 sl = (f32x4){bflo(sb.x), bfhi(sb.x), bflo(sb.y), bfhi(sb.y)}; S[x] = S[x] * d + sl; } }
        }
        unsigned rg[8], rq[8], rk[8]; u32x4 rvv[NVP];
#pragma unroll
        for (int i = 0; i < 8; ++i) { const size_t ro = (size_t)(8 * w + i) * LDQK; if (!GFROMK) rg[i] = *(const unsigned*)(gp + ro + lqk); rk[i] = *(const unsigned*)(kp + ro + lqk); if (PASS == 3) rq[i] = *(const unsigned*)(qp + ro + lqk); }
        constexpr bool VPRE = (NX <= 8) || (PASS == 1);
        if (VPRE) {
#pragma unroll
            for (int j = 0; j < NVP; ++j) rvv[j] = *(const u32x4*)(vp + (size_t)(RPP * j) * 1024 + lv); }
        for (int n = 0; n < CPS; ++n) {
            if (!VPRE) {
#pragma unroll
                for (int j = 0; j < NVP; ++j) rvv[j] = *(const u32x4*)(vp + (size_t)(n * 64 + RPP * j) * 1024 + lv); }
            float c0[8], c1[8]; float a0 = 0.f, a1 = 0.f;
#pragma unroll
            for (int i = 0; i < 8; ++i) { if (GFROMK) { a0 += __log2f(1.0f - bflo(rk[i])); a1 += __log2f(1.0f - bfhi(rk[i])); } else { a0 += bflo(rg[i]); a1 += bfhi(rg[i]); } c0[i] = a0; c1[i] = a1; }
            *(LAS f32x2*)(lds + SC_SEG + w * 512 + lane * 8) = (f32x2){a0, a1};
            SCAN_BAR();
            float off0 = 0.f, off1 = 0.f, tot0 = 0.f, tot1 = 0.f;
#pragma unroll
            for (int ww = 0; ww < 8; ++ww) { const f32x2 s = *(const LAS f32x2*)(lds + SC_SEG + ww * 512 + lane * 8); if (ww < w) { off0 += s.x; off1 += s.y; } tot0 += s.x; tot1 += s.y; }
            if (w == 0) *(LAS f32x2*)(lds + SC_EBL + lane * 8) = (f32x2){__builtin_amdgcn_exp2f(tot0), __builtin_amdgcn_exp2f(tot1)};
#pragma unroll
            for (int i = 0; i < 8; ++i) {
                const float b0 = off0 + c0[i], b1 = off1 + c1[i];
                const float i0 = __builtin_amdgcn_exp2f(-b0), i1 = __builtin_amdgcn_exp2f(-b1);
                *(LAS unsigned*)(lds + SC_KT + offb(8 * w + i, lane >> 2) + 4 * (lane & 3)) = pk2(bflo(rk[i]) * i0, bfhi(rk[i]) * i1);
                if (PASS == 3) { const float e0 = __builtin_amdgcn_exp2f(b0), e1 = __builtin_amdgcn_exp2f(b1);
                    *(LAS unsigned*)(lds + SC_QB + (8 * w + i) * PQ + lane * 4) = pk2(bflo(rq[i]) * e0, bfhi(rq[i]) * e1); }
            }
#pragma unroll
            for (int j = 0; j < NVP; ++j) { const int c8 = tid % CPR; *(LAS u32x4*)(lds + SC_V + (c8 >> 4) * 16384 + offb(tid / CPR + RPP * j, c8 & 15)) = rvv[j]; }
            if (PASS == 3) {
#pragma unroll
                for (int x = 0; x < NX; ++x) { u32x2 sv; sv.x = pk2(S[x][0], S[x][1]); sv.y = pk2(S[x][2], S[x][3]);
                    *(LAS u32x2*)(lds + SC_ST + (16 * x + fr) * PQ + (16 * w + 4 * fq) * 2) = sv; } }
            SCAN_BAR();
            if (n + 1 < CPS) {
#pragma unroll
                for (int i = 0; i < 8; ++i) { const size_t ro = (size_t)((n + 1) * 64 + 8 * w + i) * LDQK; if (!GFROMK) rg[i] = *(const unsigned*)(gp + ro + lqk); rk[i] = *(const unsigned*)(kp + ro + lqk); if (PASS == 3) rq[i] = *(const unsigned*)(qp + ro + lqk); }
                if (VPRE) {
#pragma unroll
                    for (int j = 0; j < NVP; ++j) rvv[j] = *(const u32x4*)(vp + (size_t)((n + 1) * 64 + RPP * j) * 1024 + lv); }
            }
            if (PASS == 3) {
                f32x4 oacc[NXH];
                bf16x8 qf[4];
#pragma unroll
                for (int ks = 0; ks < 4; ++ks) qf[ks] = *(const LAS bf16x8*)(lds + SC_QB + (16 * tb + fr) * PQ + (32 * ks + 8 * fq) * 2);
#pragma unroll
                for (int xx = 0; xx < NXH; ++xx) { oacc[xx] = (f32x4){0.f, 0.f, 0.f, 0.f};
#pragma unroll
                    for (int ks = 0; ks < 4; ++ks) { const bf16x8 sf = *(const LAS bf16x8*)(lds + SC_ST + (16 * (NXH * vh + xx) + fr) * PQ + (32 * ks + 8 * fq) * 2); oacc[xx] = MFMA16(sf, qf[ks], oacc[xx]); }
                    if ((xx & 1) == 1) __builtin_amdgcn_sched_barrier(0); }
#pragma unroll
                for (int e = 0; e < 2; ++e) { const int sb = 2 * vh + e;
                    f32x4 pacc = (f32x4){0.f, 0.f, 0.f, 0.f};
                    if (sb <= tb) {
#pragma unroll
                        for (int ks = 0; ks < 4; ++ks) { const bf16x8 kf = *(const LAS bf16x8*)(lds + SC_KT + offb(16 * sb + fr, 4 * ks + fq)); pacc = MFMA16(kf, qf[ks], pacc); }
                        if (sb == tb) {
#pragma unroll
                            for (int j = 0; j < 4; ++j) if (4 * fq + j > fr) pacc[j] = 0.f; }
                    }
                    u32x2 pv; pv.x = pk2(pacc[0], pacc[1]); pv.y = pk2(pacc[2], pacc[3]);
                    *(LAS u32x2*)(lds + SC_P + (16 * tb + fr) * PS + (16 * sb + 4 * fq) * 2) = pv; }
                SCAN_BAR();
                u32x2 gt[NXH];
#pragma unroll
                for (int xx = 0; xx < NXH; ++xx) gt[xx] = *(const u32x2*)(gtp + (size_t)(n * 64) * 1024 + 16 * xx + lo);
#pragma unroll
                for (int ks = 0; ks < 2; ++ks) { if (ks == 1 && tb < 2) continue;
                    const bf16x8 pf = *(const LAS bf16x8*)(lds + SC_P + (16 * tb + fr) * PS + (32 * ks + 8 * fq) * 2);
#pragma unroll
                    for (int xx = 0; xx < NXH; ++xx) { const int c = NXH * vh + xx; const bf16x8 vf = tr_frag(lds, SC_V + (c >> 3) * 16384, c & 7, ks, LX); oacc[xx] = MFMA16(vf, pf, oacc[xx]);
                        if ((xx & 3) == 3) __builtin_amdgcn_sched_barrier(0); } }
                float part = 0.f;
#pragma unroll
                for (int xx = 0; xx < NXH; ++xx) part += (oacc[xx][0] * oacc[xx][0] + oacc[xx][1] * oacc[xx][1]) + (oacc[xx][2] * oacc[xx][2] + oacc[xx][3] * oacc[xx][3]);
                part += __shfl_xor(part, 16); part += __shfl_xor(part, 32);
                if (fq == 0) *(LAS float*)(lds + SC_NRM + ((tb * 2 + vh) * 16 + fr) * 4) = part;
                SCAN_BAR();
                const float ssq = *(const LAS float*)(lds + SC_NRM + ((tb * 2) * 16 + fr) * 4) + *(const LAS float*)(lds + SC_NRM + ((tb * 2 + 1) * 16 + fr) * 4);
                const float rstd = 1.0f / sqrtf(ssq * (1.0f / DVH) + EPS);
#pragma unroll
                for (int xx = 0; xx < NXH; ++xx) { const f32x4 nwv = *(const f32x4*)(nw + 16 * NXH * vh + 16 * xx + 4 * fq);
                    const float g0 = bflo(gt[xx].x), g1 = bfhi(gt[xx].x), g2 = bflo(gt[xx].y), g3 = bfhi(gt[xx].y);
                    u32x2 ov; ov.x = pk2(oacc[xx][0] * rstd * nwv[0] * pg8::fsilu(g0), oacc[xx][1] * rstd * nwv[1] * pg8::fsilu(g1));
                    ov.y = pk2(oacc[xx][2] * rstd * nwv[2] * pg8::fsilu(g2), oacc[xx][3] * rstd * nwv[3] * pg8::fsilu(g3));
                    *(u32x2*)(op + (size_t)(n * 64) * 1024 + 16 * xx + lo) = ov;
                    if ((xx & 1) == 1) __builtin_amdgcn_sched_barrier(0); }
            }
            const f32x4 ebl = *(const LAS f32x4*)(lds + SC_EBL + (16 * w + 4 * fq) * 4);
            if (PASS == 1) dacc = dacc * ebl;
#pragma unroll
            for (int ks = 0; ks < 2; ++ks) { const bf16x8 af = tr_frag(lds, SC_KT, w, ks, LX);
#pragma unroll
                for (int x = 0; x < NX; ++x) { const bf16x8 bfv = tr_frag(lds, SC_V + (x >> 3) * 16384, x & 7, ks, LX); S[x] = MFMA16(af, bfv, S[x]);
                    if ((x & 3) == 3) __builtin_amdgcn_sched_barrier(0); } }
#pragma unroll
            for (int x = 0; x < NX; ++x) S[x] = S[x] * ebl;
        }
        if (PASS == 1) {
#pragma unroll
            for (int x = 0; x < NX; ++x) { u32x2 sb; sb.x = pk2(S[x][0], S[x][1]); sb.y = pk2(S[x][2], S[x][3]); *((u32x2*)SLOC + (((size_t)u * 8 + w) * NX + x) * 64 + lane) = sb; }
            if (fr == 0) *(f32x4*)(DSEG + (size_t)u * 128 + 16 * w + 4 * fq) = dacc;
        }
        SCAN_BAR();
    }
}
constexpr int NPHASE = 14;
__global__ void __launch_bounds__(512, 2) fwd_kernel(Args a, int ph_lo, int ph_hi) {
    extern __shared__ __attribute__((aligned(16))) unsigned char lds_raw[];
    LAS unsigned char* lds = (LAS unsigned char*)lds_raw;
    cg::grid_group grid = cg::this_grid();
    if (threadIdx.x < 4) ((volatile LAS unsigned*)(lds + XB_LDS_OFF))[threadIdx.x] = 0u;
    __syncthreads();
    XcdBarrier xbar = xcd_barrier_post((unsigned*)(a.ws + WS_BAR), (volatile LAS unsigned*)(lds + XB_LDS_OFF));
    const int G = gridDim.x, bx = blockIdx.x;
    unsigned char* ws = a.ws;
    const float* x = a.in[0]; const float* lb_logits = a.in[1]; const float* hg_w_in = a.in[2]; const float* hg_norm_w = a.in[3]; const float* hg_w_out = a.in[4];
    const float* gla_w_in = a.in[5]; const float* gla_w_gk = a.in[6]; const float* gla_b_gk = a.in[7]; const float* gla_norm_w = a.in[8]; const float* gla_w_out = a.in[9];
    const float* norm_mixer_w = a.in[10]; const float* norm_ffn_w = a.in[11]; const float* ffn_w_up = a.in[12]; const float* ffn_conv_w = a.in[13]; const float* ffn_conv_b = a.in[14];
    const float* ffn_w_down = a.in[15]; const float* norm_final_w = a.in[16];
    float* hres = a.out;
    float* LB = (float*)(ws + WS_LB);
    bf16_t* WT_HG_IN = (bf16_t*)(ws + WS_WT_HG_IN); bf16_t* WT_HG_OUT = (bf16_t*)(ws + WS_WT_HG_OUT); bf16_t* WT_GLA_IN = (bf16_t*)(ws + WS_WT_GLA_IN); bf16_t* WT_GLA_OUT = (bf16_t*)(ws + WS_WT_GLA_OUT);
    bf16_t* Y = (bf16_t*)(ws + WS_Y); bf16_t* ORAW = (bf16_t*)(ws + WS_ORAW); bf16_t* ACT = (bf16_t*)(ws + WS_ACT);
    bf16_t* PQ_ = (bf16_t*)(ws + WS_P);
    bf16_t* PK_ = (bf16_t*)(ws + WS_P + 64 * MiB);
    bf16_t* PG_ = (bf16_t*)(ws + WS_P + 128 * MiB);
    bf16_t* PV_ = (bf16_t*)(ws + WS_P + 192 * MiB);
    bf16_t* PGATE = (bf16_t*)(ws + WS_P + 256 * MiB);


    constexpr int I0 = 16 * 64, I1 = 16 * 16, I2 = 16 * 48, I3 = 16 * 16, I4 = 16 * 88, I5 = 44 * 16, NIT = I0 + I1 + I2 + I3 + 2 * I4 + 2 * I5;
#pragma unroll 1
    for (int ph = ph_lo; ph < ph_hi;) {
        int tid_ = threadIdx.x; asm volatile("" : "+v"(tid_)); const int tid = tid_, lane = tid & 63, wave = __builtin_amdgcn_readfirstlane(tid >> 6);
        const int gw = bx * 8 + wave, ngw = G * 8, gtid = bx * 512 + tid, ngt = G * 512;
        int type = 0;
        const bf16_t* gA = Y; const bf16_t* gB = WT_HG_IN; int gM = MROWS, gN = 1024, gK = 1024, kind = 0, L = 0; const float* aux = LB; const float* base = x; float* outp = hres;
        bf16_t* hbp = nullptr; const bf16_t* baseb = nullptr; unsigned long long* ssqp = nullptr; const unsigned long long* rsp = nullptr; int nof32 = 0;
        unsigned long long* SSQ = (unsigned long long*)(ws + WS_SSQ); bf16_t* HALO = (bf16_t*)(ws + WS_HALO);
        bf16_t* HB2 = (bf16_t*)hres;
        int p = ph;
        if (p >= 7) L = 1;
        if (p >= 4 && p < 7) p = p - 4 + 100; else if (p >= 10 && p < 13) p = p - 10 + 100;
        const bf16_t* WTU = (const bf16_t*)(ws + (L == 0 ? WS_WT_UP0 : WS_WT_UP1)); const bf16_t* WTD = (const bf16_t*)(ws + (L == 0 ? WS_WT_DN0 : WS_WT_DN1));
        const float* cwp = ffn_conv_w + (size_t)L * 3 * NUP; const float* cbp = ffn_conv_b + (size_t)L * NUP;
        unsigned long long* ssq_mix = SSQ + (size_t)(L == 0 ? 0 : 2) * MROWS; unsigned long long* ssq_ffn = SSQ + (size_t)1 * MROWS;
        switch (p) {
            case 0: type = 0; break;
            case 1: type = 1; gA = Y; gB = WT_HG_IN; gN = 4096; kind = 0; aux = LB; break;
            case 2: type = 3; break;
            case 3: type = 2; gA = Y; gB = WT_HG_OUT; base = x; outp = hres; hbp = ORAW; ssqp = ssq_mix; nof32 = 1; break;
            case 7: type = 1; gA = HB2; gB = WT_GLA_IN; gN = NGLA; kind = 1; aux = gla_b_gk; rsp = ssq_ffn; break;
            case 8: type = 3; break;
            case 9: type = 2; gA = Y; gB = WT_GLA_OUT; base = hres; baseb = HB2; outp = hres; hbp = ORAW; ssqp = ssq_mix; nof32 = 1; break;
            case 13: type = 7; break;
            case 100: type = 1; gA = ORAW; gB = WTU; gN = NUP; kind = 3; rsp = ssq_mix; break;
            case 101: type = 6; break;
            default: type = 2; gA = ACT; gB = WTD; gK = DFF; base = hres; baseb = ORAW; outp = hres; hbp = (L == 0) ? HB2 : Y; ssqp = (L == 0) ? ssq_ffn : SSQ + (size_t)3 * MROWS; nof32 = 1; break;
        }
        if (type == 0) {
            for (int e = gtid; e < 4 * MROWS; e += ngt) SSQ[e] = 0ull;
            LAS float* scr = (LAS float*)(lds + wave * 16384);
            for (int it = gw; it < NIT; it += ngw) {
                int r = it;
                if (r < I0) { p0_transpose_item64(hg_w_in, 1024, 4096, 64, WT_HG_IN, scr, r, lane); continue; } r -= I0;
                if (r < I1) { p0_transpose_item64(hg_w_out, 1024, 1024, 16, WT_HG_OUT, scr, r, lane, nullptr, false, true); continue; } r -= I1;
                if (r < I2) { p0_transpose_item64(gla_w_in, 1024, GLA_IN, 48, WT_GLA_IN, scr, r, lane, norm_mixer_w + 1024, false, true); continue; } r -= I2;
                if (r < I3) { p0_transpose_item64(gla_w_out, 1024, 1024, 16, WT_GLA_OUT, scr, r, lane, nullptr, false, true); continue; } r -= I3;
                if (r < I4) { p0_transpose_item64(ffn_w_up, 1024, NUP, 88, (bf16_t*)(ws + WS_WT_UP0), scr, r, lane, norm_ffn_w, true, true); continue; } r -= I4;
                if (r < I4) { p0_transpose_item64(ffn_w_up + (size_t)1024 * NUP, 1024, NUP, 88, (bf16_t*)(ws + WS_WT_UP1), scr, r, lane, norm_ffn_w + 1024, true, true); continue; } r -= I4;
                if (r < I5) { p0_transpose_item64(ffn_w_down, DFF, 1024, 16, (bf16_t*)(ws + WS_WT_DN0), scr, r, lane, nullptr, false, true); continue; } r -= I5;
                p0_transpose_item64(ffn_w_down + (size_t)DFF * 1024, DFF, 1024, 16, (bf16_t*)(ws + WS_WT_DN1), scr, r, lane, nullptr, false, true);
            }
            for (int e = gtid; e < 32 * 1024; e += ngt) { const int k = e & 1023, ng = e >> 10; const float* wi = gla_w_in + (size_t)k * GLA_IN + 3072; const float nwk = norm_mixer_w[1024 + k];
                const f32x4 w0 = *(const f32x4*)(wi) * nwk, w1 = *(const f32x4*)(wi + 4) * nwk, w2 = *(const f32x4*)(wi + 8) * nwk, w3 = *(const f32x4*)(wi + 12) * nwk;
#pragma unroll 4
                for (int nn = 0; nn < 16; ++nn) { const int n = ng * 16 + nn; const float* gk = gla_w_gk + n;
                    float s = w0[0] * gk[0] + w0[1] * gk[512] + w0[2] * gk[1024] + w0[3] * gk[1536];
                    s += w1[0] * gk[2048] + w1[1] * gk[2560] + w1[2] * gk[3072] + w1[3] * gk[3584];
                    s += w2[0] * gk[4096] + w2[1] * gk[4608] + w2[2] * gk[5120] + w2[3] * gk[5632];
                    s += w3[0] * gk[6144] + w3[1] * gk[6656] + w3[2] * gk[7168] + w3[3] * gk[7680];
                    WT_GLA_IN[(size_t)(3072 + n) * 1024 + k] = (bf16_t)f2bf(s); } }

            if (gtid < 1024) { const float l0 = lb_logits[gtid], l1 = lb_logits[1024 + gtid], l2 = lb_logits[2048 + gtid]; const float mx = fmaxf(l0, fmaxf(l1, l2));
                const float e0 = __expf(l0 - mx), e1 = __expf(l1 - mx), e2 = __expf(l2 - mx); LB[gtid] = e0 / (e0 + e1 + e2); }
            rms_phase(x, norm_mixer_w, Y, gw, ngw, lane);
        }
        if (type == 2) { pg8::Gemm g{gA, gB, gM, gN, gK}; pg8::StaticOrder S; S.init(gM, gN, G, bx);
            pg8::EpiRes E{base, outp, 1024, baseb, hbp, ssqp, (hbp == ORAW) ? 1 : 0, nof32}; pg8::gemm_phase<pg8::EpiRes, pg8::StaticOrder, true, true>(lds, g, S, E); }
        if (type == 1) { pg8::Gemm g{gA, gB, gM, gN, gK}; pg8::StaticOrder S; S.init(gM, gN, G, bx);
            pg8::EpiProj E{kind, kind == 3 ? ACT : PQ_, PK_, PG_, PV_, PGATE, aux, NUP, cwp, cbp, HALO, rsp}; pg8::gemm_phase<pg8::EpiProj, pg8::StaticOrder, true, true>(lds, g, S, E); }
        if (type == 3) {
            float* SLOC = (float*)(ws + WS_ORAW); float* DSEG = SLOC + 12 * 1024 * 1024;
            if (L == 0) scan_phase<1024, 8, 1>(lds, PQ_, PK_, PG_, PV_, Y, SLOC, DSEG, PGATE, hg_norm_w, bx, G); else scan_phase<512, 4, 1>(lds, PQ_, PK_, PG_, PV_, Y, SLOC, DSEG, PGATE, gla_norm_w, bx, G);
            xcd_barrier(xbar);
            if (L == 0) scan_phase<1024, 8, 3>(lds, PQ_, PK_, PG_, PV_, Y, SLOC, DSEG, PGATE, hg_norm_w, bx, G); else scan_phase<512, 4, 3>(lds, PQ_, PK_, PG_, PV_, Y, SLOC, DSEG, PGATE, gla_norm_w, bx, G); }
        if (type == 6) glu_fixup_phase(HALO, ACT, cwp, cbp, gtid, ngt);
        if (type == 7) rms_final_bf16_phase(Y, SSQ + (size_t)3 * MROWS, norm_final_w, hres, gw, ngw, lane);
        ++ph;
        if (ph < ph_hi) { if (ph_lo < 0) grid.sync(); else xcd_barrier(xbar); }
    }

}

extern "C" void kernel_launch(void* const* d_in, const int* in_sizes, int n_in, void* d_out, int out_size, void* d_ws, size_t ws_size, hipStream_t stream) {
    static int grid = 0;
    if (grid == 0) {
        int dev = 0, cus = 0, per_cu = 0;
        hipGetDevice(&dev);
        hipDeviceGetAttribute(&cus, hipDeviceAttributeMultiprocessorCount, dev);
        hipFuncSetAttribute((const void*)fwd_kernel, hipFuncAttributeMaxDynamicSharedMemorySize, LDS_BYTES);
        hipOccupancyMaxActiveBlocksPerMultiprocessor(&per_cu, (const void*)fwd_kernel, 512, LDS_BYTES);
        if (per_cu < 1) per_cu = 1;
        grid = cus * per_cu;
        if (n_in != 17 || ws_size < WS_END) fprintf(stderr, "kernel_launch: unexpected n_in %d or ws_size %zu\n", n_in, ws_size);
    }
    hipMemsetAsync((char*)d_ws + WS_BAR, 0, XCD_BAR_WORDS * 4, stream);
    Args a{};
    for (int i = 0; i < 17; ++i) a.in[i] = (const float*)d_in[i];
    a.out = (float*)d_out; a.ws = (unsigned char*)d_ws;
    int lo = 0, hi = NPHASE;
    void* args[] = {&a, &lo, &hi};
    hipError_t e = hipLaunchCooperativeKernel((const void*)fwd_kernel, dim3(grid), dim3(512), args, LDS_BYTES, stream);
    if (e != hipSuccess) fprintf(stderr, "cooperative launch failed: %s (grid %d)\n", hipGetErrorString(e), grid);
}
```
